# Optimizing an MI355X kernel written in HIP

```python
import jax, jax.numpy as jnp
from jax import lax
import numpy as np


D_MODEL = 2048
BATCH = 16
SEQ = 2048
DEPTH = 2
DEC_BATCH = 4
DEC_SEQ = 4096
PAST_LEN = 128

N_META = 16
D_MIX = D_MODEL
D_CONV = D_MIX // 4
D_LRU = D_MIX // 2
D_POOL = D_MIX // 4
N_LRU_HEADS = 8
LRU_HEAD_DIM = D_LRU // N_LRU_HEADS
POOL_WINDOWS = (2, 4, 8, 16)
N_POOL_GROUPS = len(POOL_WINDOWS)
POOL_GROUP_DIM = D_POOL // N_POOL_GROUPS
SHORT_CONV_WIDTH = 3
LRU_CONV_WIDTH = 4
LRU_C = 8.0
D_FF = 5632
D_IN_PROJ = 3 * D_CONV + 2 * D_LRU + D_POOL
IN_PROJ_SPLITS = (D_CONV, 2 * D_CONV, 3 * D_CONV, 3 * D_CONV + D_LRU, 3 * D_CONV + 2 * D_LRU)
DEEPNORM_ALPHA = (2 * DEPTH) ** 0.25
DEEPNORM_BETA = (8 * DEPTH) ** -0.25
LN_EPS = 1e-5

kernel_name = 'hymba_parallel_conv_rglru_pool_encoder'


def _layernorm(x, g, b):
    xf = x.astype(jnp.float32)
    mu = jnp.mean(xf, axis=-1, keepdims=True)
    var = jnp.mean(jnp.square(xf - mu), axis=-1, keepdims=True)
    y = (xf - mu) * lax.rsqrt(var + LN_EPS) * g.astype(jnp.float32) + b.astype(jnp.float32)
    return y.astype(x.dtype)


def _post_norm(x, sub, g, b):
    return _layernorm(DEEPNORM_ALPHA * x + sub, g, b)


def _swiglu(x, w_gate, w_up, w_down):
    return (jax.nn.silu(x @ w_gate) * (x @ w_up)) @ w_down


def _short_conv_mixer(b_gate, c_gate, v, conv_w, conv_b):
    u = c_gate * v
    L = u.shape[1]
    pad = SHORT_CONV_WIDTH // 2
    up = jnp.pad(u, ((0, 0), (pad, pad), (0, 0)))
    y = conv_b + sum(up[:, k:k + L] * conv_w[k] for k in range(SHORT_CONV_WIDTH))
    return b_gate * y


def _causal_conv(u, w, b):
    K = w.shape[0]
    L = u.shape[1]
    up = jnp.pad(u, ((0, 0), (K - 1, 0), (0, 0)))
    return b + sum(up[:, k:k + L] * w[k] for k in range(K))


def _linear_combine(left, right):
    a1, b1 = left
    a2, b2 = right
    return a1 * a2, a2 * b1 + b2


def _rglru_direction(u, conv_w, conv_b, w_a, b_a, w_x, b_x, lam):
    xc = _causal_conv(u, conv_w, conv_b)
    Bsz, L, _ = xc.shape
    xh = xc.reshape(Bsz, L, N_LRU_HEADS, LRU_HEAD_DIM)
    r = jax.nn.sigmoid(jnp.einsum('blhi,hij->blhj', xh, w_a).reshape(Bsz, L, D_LRU) + b_a)
    i = jax.nn.sigmoid(jnp.einsum('blhi,hij->blhj', xh, w_x).reshape(Bsz, L, D_LRU) + b_x)
    log_a = (-LRU_C * jax.nn.softplus(-lam.astype(jnp.float32))) * r.astype(jnp.float32)
    a = jnp.exp(log_a)
    mult = jnp.sqrt(-jnp.expm1(2.0 * log_a))
    bterm = mult * (i * xc).astype(jnp.float32)
    _, h = lax.associative_scan(_linear_combine, (a, bterm), axis=1)
    return h.astype(u.dtype)


def _bidirectional_rglru(lru_x, lru_gate, conv_w, conv_b, w_a, b_a, w_x, b_x, lam):
    h_f = _rglru_direction(lru_x, conv_w[0], conv_b[0], w_a[0], b_a[0], w_x[0], b_x[0], lam[0])
    h_b = jnp.flip(_rglru_direction(jnp.flip(lru_x, axis=1), conv_w[1], conv_b[1], w_a[1], b_a[1],
                                    w_x[1], b_x[1], lam[1]), axis=1)
    return jax.nn.gelu(lru_gate) * (h_f + h_b)


def _pool_mixer(u, pool_w, pool_scale):
    Bsz, L, _ = u.shape
    uf = u.astype(jnp.float32)
    cs = jnp.concatenate([jnp.zeros((Bsz, 1, D_POOL), jnp.float32), jnp.cumsum(uf, axis=1)], axis=1)
    t = jnp.arange(L)
    outs = []
    for g, w in enumerate(POOL_WINDOWS):
        lo = jnp.maximum(t - w // 2, 0)
        hi = jnp.minimum(t + w // 2 - 1, L - 1)
        sl = slice(g * POOL_GROUP_DIM, (g + 1) * POOL_GROUP_DIM)
        csg = cs[..., sl]
        win_sum = jnp.take(csg, hi + 1, axis=1) - jnp.take(csg, lo, axis=1)
        count = (hi - lo + 1).astype(jnp.float32)[None, :, None]
        outs.append(win_sum / count - uf[..., sl])
    pooled = jnp.stack(outs, axis=2)
    mixed = jnp.einsum('blgi,gij->blgj', pooled, pool_w.astype(jnp.float32)).reshape(Bsz, L, D_POOL)
    return (mixed * pool_scale.astype(jnp.float32)).astype(u.dtype)


def _trunk(x, meta_tokens, ln_in_g, ln_in_b, ffn1_w_gate, ffn1_w_up, ffn1_w_down, ln1_g, ln1_b,
           w_in, conv_w, conv_b, lru_conv_w, lru_conv_b, lru_w_a, lru_b_a, lru_w_x, lru_b_x, lru_lambda,
           pool_w, pool_scale, w_out, ln2_g, ln2_b, ffn2_w_gate, ffn2_w_up, ffn2_w_down, ln3_g, ln3_b):
    Bsz = x.shape[0]
    meta = jnp.broadcast_to(meta_tokens.astype(x.dtype)[None], (Bsz, N_META, D_MODEL))
    h = _layernorm(jnp.concatenate([meta, x], axis=1), ln_in_g, ln_in_b)
    for l in range(DEPTH):
        h = _post_norm(h, 0.5 * _swiglu(h, ffn1_w_gate[l], ffn1_w_up[l], ffn1_w_down[l]), ln1_g[l], ln1_b[l])
        proj = h @ w_in[l]
        b_gate, c_gate, v, lru_x, lru_gate, pool_in = jnp.split(proj, IN_PROJ_SPLITS, axis=-1)
        y_conv = _short_conv_mixer(b_gate, c_gate, v, conv_w[l], conv_b[l])
        y_lru = _bidirectional_rglru(lru_x, lru_gate, lru_conv_w[l], lru_conv_b[l], lru_w_a[l], lru_b_a[l],
                                     lru_w_x[l], lru_b_x[l], lru_lambda[l])
        y_pool = _pool_mixer(pool_in, pool_w[l], pool_scale[l])
        mix = jnp.concatenate([y_conv, y_lru, y_pool], axis=-1) @ w_out[l]
        h = _post_norm(h, mix, ln2_g[l], ln2_b[l])
        h = _post_norm(h, 0.5 * _swiglu(h, ffn2_w_gate[l], ffn2_w_up[l], ffn2_w_down[l]), ln3_g[l], ln3_b[l])
    return h[:, N_META:]


def setup_inputs(seed: int = 0) -> dict:
    key = jax.random.key(seed)
    ks = jax.random.split(key, 32)
    f32 = jnp.float32

    def nrm(k, shape, scale):
        return jax.random.normal(k, shape, f32) * scale

    def gain(k, shape):
        return 1.0 + 0.02 * jax.random.normal(k, shape, f32)

    u = jax.random.uniform(ks[17], (DEPTH, 2, D_LRU), f32, minval=0.9, maxval=0.999)
    a_base = u ** (1.0 / LRU_C)
    lru_lambda = jnp.log(a_base) - jnp.log1p(-a_base)

    return {
        'x_prompt': nrm(ks[0], (BATCH, SEQ, D_MODEL), 1.0),
        'x_sample': nrm(ks[1], (DEC_BATCH, DEC_SEQ, D_MODEL), 1.0),
        'meta_tokens': nrm(ks[2], (N_META, D_MODEL), 1.0),
        'ln_in_g': gain(ks[3], (D_MODEL,)),
        'ln_in_b': nrm(ks[4], (D_MODEL,), 0.02),
        'ffn1_w_gate': nrm(ks[5], (DEPTH, D_MODEL, D_FF), D_MODEL ** -0.5),
        'ffn1_w_up': nrm(ks[6], (DEPTH, D_MODEL, D_FF), D_MODEL ** -0.5),
        'ffn1_w_down': nrm(ks[7], (DEPTH, D_FF, D_MODEL), DEEPNORM_BETA * D_FF ** -0.5),
        'ln1_g': gain(ks[8], (DEPTH, D_MODEL)),
        'ln1_b': nrm(ks[9], (DEPTH, D_MODEL), 0.02),
        'w_in': nrm(ks[10], (DEPTH, D_MODEL, D_IN_PROJ), D_MODEL ** -0.5),
        'conv_w': nrm(ks[11], (DEPTH, SHORT_CONV_WIDTH, D_CONV), SHORT_CONV_WIDTH ** -0.5),
        'conv_b': nrm(ks[12], (DEPTH, D_CONV), 0.02),
        'lru_conv_w': nrm(ks[13], (DEPTH, 2, LRU_CONV_WIDTH, D_LRU), LRU_CONV_WIDTH ** -0.5),
        'lru_conv_b': nrm(ks[14], (DEPTH, 2, D_LRU), 0.02),
        'lru_w_a': nrm(ks[15], (DEPTH, 2, N_LRU_HEADS, LRU_HEAD_DIM, LRU_HEAD_DIM), LRU_HEAD_DIM ** -0.5),
        'lru_b_a': nrm(ks[16], (DEPTH, 2, D_LRU), 0.02),
        'lru_w_x': nrm(ks[18], (DEPTH, 2, N_LRU_HEADS, LRU_HEAD_DIM, LRU_HEAD_DIM), LRU_HEAD_DIM ** -0.5),
        'lru_b_x': nrm(ks[19], (DEPTH, 2, D_LRU), 0.02),
        'lru_lambda': lru_lambda,
        'pool_w': nrm(ks[20], (DEPTH, N_POOL_GROUPS, POOL_GROUP_DIM, POOL_GROUP_DIM), POOL_GROUP_DIM ** -0.5),
        'pool_scale': gain(ks[21], (DEPTH, D_POOL)),
        'w_out': nrm(ks[22], (DEPTH, D_MIX, D_MODEL), DEEPNORM_BETA * D_MIX ** -0.5),
        'ln2_g': gain(ks[23], (DEPTH, D_MODEL)),
        'ln2_b': nrm(ks[24], (DEPTH, D_MODEL), 0.02),
        'ffn2_w_gate': nrm(ks[25], (DEPTH, D_MODEL, D_FF), D_MODEL ** -0.5),
        'ffn2_w_up': nrm(ks[26], (DEPTH, D_MODEL, D_FF), D_MODEL ** -0.5),
        'ffn2_w_down': nrm(ks[27], (DEPTH, D_FF, D_MODEL), DEEPNORM_BETA * D_FF ** -0.5),
        'ln3_g': gain(ks[28], (DEPTH, D_MODEL)),
        'ln3_b': nrm(ks[29], (DEPTH, D_MODEL), 0.02),
    }


def reference(x_prompt, x_sample, meta_tokens, ln_in_g, ln_in_b, ffn1_w_gate, ffn1_w_up, ffn1_w_down,
              ln1_g, ln1_b, w_in, conv_w, conv_b, lru_conv_w, lru_conv_b, lru_w_a, lru_b_a, lru_w_x, lru_b_x,
              lru_lambda, pool_w, pool_scale, w_out, ln2_g, ln2_b, ffn2_w_gate, ffn2_w_up, ffn2_w_down,
              ln3_g, ln3_b):
    weights = (meta_tokens, ln_in_g, ln_in_b, ffn1_w_gate, ffn1_w_up, ffn1_w_down, ln1_g, ln1_b,
               w_in, conv_w, conv_b, lru_conv_w, lru_conv_b, lru_w_a, lru_b_a, lru_w_x, lru_b_x, lru_lambda,
               pool_w, pool_scale, w_out, ln2_g, ln2_b, ffn2_w_gate, ffn2_w_up, ffn2_w_down, ln3_g, ln3_b)
    y_prompt = _trunk(x_prompt, *weights)
    y_sample = _trunk(x_sample, *weights)
    return (y_prompt, y_sample)
```

```cpp
#include <hip/hip_runtime.h>
#include <hip/hip_cooperative_groups.h>
#include <cstdio>
#include <cstdint>
namespace cg = cooperative_groups;

#ifndef MK_MULTI
#define MK_MULTI 0
#endif

#ifndef PROBE_REP
#define PROBE_REP 0
#endif
#define LAS __attribute__((address_space(3)))
typedef unsigned short bf16_t;
typedef short bf16x8 __attribute__((ext_vector_type(8)));
typedef float f32x4 __attribute__((ext_vector_type(4)));
typedef float f32x2 __attribute__((ext_vector_type(2)));
typedef unsigned u32x4 __attribute__((ext_vector_type(4)));
typedef unsigned u32x2 __attribute__((ext_vector_type(2)));

constexpr int D = 2048, FF = 5632, DIN = 4096, DEPTH = 2;
constexpr int NTOK = 49152;
constexpr int NMETA = 16, NSEQ = 20;
constexpr int TREAL = NTOK + NSEQ * NMETA;
constexpr int TP = 49664;
constexpr int DLRU = 1024, DCONV = 512, DPOOL = 512;
constexpr float ALPHA = 1.41421356237f;
constexpr float LN_EPS = 1e-5f;
constexpr int LDS_BYTES = 131072 + 16384 + 16;
constexpr int LDS_GB = 131072;

constexpr size_t WS_HB = 0;
constexpr size_t WS_XM = WS_HB + (size_t)TP * D * 2;
constexpr size_t WS_ST = WS_XM + (size_t)512 * D * 4;
constexpr size_t WS_BAR = WS_ST + (size_t)TP * 8;
constexpr size_t WS_W = WS_BAR + 16384;
constexpr size_t W_GU1 = 0, W_D1 = W_GU1 + (size_t)2 * FF * D * 2, W_GU2 = W_D1 + (size_t)D * FF * 2, W_D2 = W_GU2 + (size_t)2 * FF * D * 2,
                 W_IN = W_D2 + (size_t)D * FF * 2, W_OUT = W_IN + (size_t)DIN * D * 2, W_END = W_OUT + (size_t)D * D * 2;
constexpr size_t WS_BIG = WS_W + W_END;
constexpr size_t BIG_HFB = (size_t)TP * DIN * 2;
constexpr size_t WS_END = WS_BIG + (size_t)TP * DIN * 2 + (size_t)TP * D * 2;
constexpr size_t WS_PART = WS_END;
constexpr size_t WS_TOTAL = WS_PART + (size_t)4 * 512 * D * 4;
static_assert((size_t)TP * FF * 2 <= (size_t)TP * DIN * 2 + (size_t)TP * D * 2, "hidden fits");

struct Args { const float* in[30]; float* out; unsigned char* ws; int ph_lo, ph_hi; };

__device__ __forceinline__ unsigned cvt_pk_bf16(float lo, float hi) { unsigned r; asm volatile("v_cvt_pk_bf16_f32 %0, %1, %2" : "=v"(r) : "v"(lo), "v"(hi)); return r; }
__device__ __forceinline__ float bf_lo(unsigned w) { return __uint_as_float(w << 16); }
__device__ __forceinline__ float bf_hi(unsigned w) { return __uint_as_float(w & 0xffff0000u); }
__device__ __forceinline__ float bf1(bf16_t h) { return __uint_as_float(((unsigned)h) << 16); }
__device__ __forceinline__ float fast_sigmoid(float x) { return __builtin_amdgcn_rcpf(1.0f + __builtin_amdgcn_exp2f(-1.44269504089f * x)); }
__device__ __forceinline__ float wave_sum(float v) {
#pragma unroll
    for (int o = 1; o < 64; o <<= 1) v += __shfl_xor(v, o);
    return v;
}
__device__ __forceinline__ int ltid() { int t = threadIdx.x; asm volatile("" : "+v"(t)); return t; }
__device__ __forceinline__ int lbid() { int b = blockIdx.x; asm volatile("" : "+s"(b)); return b; }
__device__ __forceinline__ int seq_len(int s) { return s < 16 ? 2064 : 4112; }
__device__ __forceinline__ int row_of(int s, int p) {
    if (p < NMETA) return NTOK + s * NMETA + p;
    return (s < 16 ? s * 2048 : 32768 + (s - 16) * 4096) + (p - NMETA);
}

namespace pg8 {
constexpr int BM = 256, BK = 64, HALF = 128, HTB = HALF * BK * 2, STAGE_BYTES = 8 * HTB, NXCD = 8, WGM = 8;
__host__ __device__ __forceinline__ int lds_byte(int r, int c) { const int st = (r >> 4) * 2 + (c >> 5), rr = r & 15, cc = c & 31, ob = rr * 64 + cc * 2; return st * 1024 + (ob ^ (((ob >> 9) & 1) << 5)); }
__host__ __device__ __forceinline__ void stage_rc(int b, int& R, int& C) { const int st = b / 1024, sb = b % 1024, swz = sb ^ (((sb >> 9) & 1) << 5); R = (st >> 1) * 16 + swz / 64; C = (st & 1) * 32 + (swz % 64) / 2; }
__host__ __device__ __forceinline__ int perm32(int rho) { const int n = rho >> 4, i = rho & 15; return 8 * (i >> 2) + 4 * n + (i & 3); }

struct Unit { int pm, pn, kp; };
struct Gemm { const bf16_t* A; const bf16_t* Bt; int M, N, K, ld; };

struct StaticOrder {
    int nM, nN, nwg, G, c;
    __device__ void init(int M, int N, int G_, int c_) { nM = M / BM; nN = N / BM; nwg = nM * nN; G = G_; c = c_; }
    __device__ bool next(int i, Unit& u) const {
        const long L = (long)i * G + c; if (L >= nwg) return false;
        int wgid = (int)L; { const int q = nwg / NXCD, r = nwg % NXCD, xcd = wgid % NXCD, off = wgid / NXCD; wgid = (xcd < r ? xcd * (q + 1) : r * (q + 1) + (xcd - r) * q) + off; }
        const int nig = WGM * nN, gid = wgid / nig, fm = gid * WGM, gsz = (nM - fm) < WGM ? (nM - fm) : WGM;
        u.pm = fm + ((wgid % nig) % gsz); u.pn = (wgid % nig) / gsz; u.kp = 0; return true;
    }
};

struct TailOrder {
    int G, c;
    __device__ bool next(int i, Unit& u) const { const int idx = i * G + c; if (idx >= 64) return false; u.kp = idx & 3; u.pn = (idx >> 2) & 7; u.pm = 192 + (idx >> 5); return true; }
};

struct EpiBf16 {
    static constexpr bool PERM = true;
    bf16_t* O; int ldc;
    __device__ __forceinline__ void operator()(const f32x4 (&acc)[2][2][4][2], const Unit& u, int wr, int wc, int fr, int fq) const {
        const int row0 = u.pm * BM + wr * 64 + fr, col0 = u.pn * BM + wc * 32 + 8 * fq;
#pragma unroll
        for (int ai = 0; ai < 2; ++ai)
#pragma unroll
            for (int m = 0; m < 4; ++m) { bf16_t* rowp = O + (size_t)(row0 + ai * HALF + m * 16) * ldc + col0;
#pragma unroll
                for (int bj = 0; bj < 2; ++bj) { const f32x4 v0 = acc[ai][bj][m][0], v1 = acc[ai][bj][m][1];
                    u32x4 w; w.x = cvt_pk_bf16(v0[0], v0[1]); w.y = cvt_pk_bf16(v0[2], v0[3]); w.z = cvt_pk_bf16(v1[0], v1[1]); w.w = cvt_pk_bf16(v1[2], v1[3]);
                    *(u32x4*)(rowp + bj * HALF) = w; } }
    }
};
struct EpiSwiGLU {
    static constexpr bool PERM = true;
    bf16_t* O; int ldc;
    __device__ __forceinline__ void operator()(const f32x4 (&acc)[2][2][4][2], const Unit& u, int wr, int wc, int fr, int fq) const {
        const int row0 = u.pm * BM + wr * 64 + fr, col0 = u.pn * HALF + wc * 32 + 8 * fq;
#pragma unroll
        for (int ai = 0; ai < 2; ++ai)
#pragma unroll
            for (int m = 0; m < 4; ++m) { bf16_t* rowp = O + (size_t)(row0 + ai * HALF + m * 16) * ldc + col0;
                float h[8];
#pragma unroll
                for (int n = 0; n < 2; ++n)
#pragma unroll
                    for (int j = 0; j < 4; ++j) { const float g = acc[ai][0][m][n][j], up = acc[ai][1][m][n][j]; h[n * 4 + j] = g * fast_sigmoid(g) * up; }
                u32x4 w; w.x = cvt_pk_bf16(h[0], h[1]); w.y = cvt_pk_bf16(h[2], h[3]); w.z = cvt_pk_bf16(h[4], h[5]); w.w = cvt_pk_bf16(h[6], h[7]);
                *(u32x4*)rowp = w; }
    }
};
struct EpiResid {
    static constexpr bool PERM = false;
    float* X0; float* X1; int split; float alpha, scale; const f32x2* st; const LAS float* gb;
    __device__ __forceinline__ void operator()(const f32x4 (&acc)[2][2][4][2], const Unit& u, int wr, int wc, int fr, int fq) const {
        float* base = (u.pm < split) ? X0 + (size_t)u.pm * BM * D : X1 + (size_t)(u.pm - split) * BM * D;
        const int row0 = wr * 64 + fr, col0 = u.pn * BM + wc * 32 + 4 * fq;
        float ra[2][4], rb[2][4];
#pragma unroll
        for (int ai = 0; ai < 2; ++ai)
#pragma unroll
            for (int m = 0; m < 4; ++m) { const f32x2 ms = st[u.pm * BM + row0 + ai * HALF + m * 16]; ra[ai][m] = alpha * ms.y; rb[ai][m] = -ms.x * ra[ai][m]; }
#pragma unroll
        for (int ai = 0; ai < 2; ++ai) {
            asm volatile("" ::: "memory");
#pragma unroll
            for (int m = 0; m < 4; ++m) { float* rowp = base + (size_t)(row0 + ai * HALF + m * 16) * D + col0;
#pragma unroll
                for (int bj = 0; bj < 2; ++bj)
#pragma unroll
                    for (int n = 0; n < 2; ++n) { f32x4* p = (f32x4*)(rowp + bj * HALF + n * 16); const f32x4 x = *p;
                        const f32x4 gv = *(const LAS f32x4*)(gb + col0 + bj * HALF + n * 16), bv = *(const LAS f32x4*)(gb + D + col0 + bj * HALF + n * 16);
                        *p = (x * ra[ai][m] + rb[ai][m]) * gv + bv + acc[ai][bj][m][n] * scale; } }
        }
    }
};

struct EpiZ {
    static constexpr bool PERM = false;
    float* Z; const bf16_t* H;
    __device__ __forceinline__ void operator()(const f32x4 (&acc)[2][2][4][2], const Unit& u, int wr, int wc, int fr, int fq) const {
        const size_t off0 = (size_t)(u.pm * BM + wr * 64 + fr) * D + u.pn * BM + wc * 32 + 4 * fq;
#pragma unroll
        for (int ai = 0; ai < 2; ++ai) {
            u32x2 hv[4][2][2];
#pragma unroll
            for (int m = 0; m < 4; ++m)
#pragma unroll
                for (int bj = 0; bj < 2; ++bj)
#pragma unroll
                    for (int n = 0; n < 2; ++n) hv[m][bj][n] = *(const u32x2*)(H + off0 + (size_t)(ai * HALF + m * 16) * D + bj * HALF + n * 16);
#pragma unroll
            for (int m = 0; m < 4; ++m)
#pragma unroll
                for (int bj = 0; bj < 2; ++bj)
#pragma unroll
                    for (int n = 0; n < 2; ++n) { const u32x2 w = hv[m][bj][n]; const f32x4 h4 = {bf_lo(w.x), bf_hi(w.x), bf_lo(w.y), bf_hi(w.y)};
                        *(f32x4*)(Z + off0 + (size_t)(ai * HALF + m * 16) * D + bj * HALF + n * 16) = h4 * ALPHA + acc[ai][bj][m][n] * 0.5f; }
        }
    }
};
struct EpiPartial {
    static constexpr bool PERM = false;
    float* P;
    __device__ __forceinline__ void operator()(const f32x4 (&acc)[2][2][4][2], const Unit& u, int wr, int wc, int fr, int fq) const {
        float* base = P + ((size_t)u.kp * 512 + (size_t)(u.pm - NTOK / BM) * BM + wr * 64 + fr) * D + u.pn * BM + wc * 32 + 4 * fq;
#pragma unroll
        for (int ai = 0; ai < 2; ++ai)
#pragma unroll
            for (int m = 0; m < 4; ++m)
#pragma unroll
                for (int bj = 0; bj < 2; ++bj)
#pragma unroll
                    for (int n = 0; n < 2; ++n) *(f32x4*)(base + (size_t)(ai * HALF + m * 16) * D + bj * HALF + n * 16) = acc[ai][bj][m][n];
    }
};

template <class Epi, class Sched = StaticOrder, bool ALIGN_EPI = true>
__device__ __forceinline__ void gemm_phase(LAS unsigned char* lds, const Gemm g, const Sched& S, const Epi& E) {
    const int tid = ltid(), wid = __builtin_amdgcn_readfirstlane(tid >> 6), lane = tid & 63, wr = wid >> 2, wc = wid & 3, fr = lane & 15, fq = lane >> 4;
    const int K = g.K, nt = K / BK;
    unsigned voffA[2], voffB[2];
#pragma unroll
    for (int i = 0; i < 2; ++i) { int R, C; stage_rc(tid * 16 + i * 8192, R, C); const int Rb = Epi::PERM ? ((R & ~31) + perm32(R & 31)) : R;
        voffA[i] = (unsigned)(R * g.ld + C) * 2u; voffB[i] = (unsigned)(Rb * g.ld + C) * 2u; }
    const size_t kstep = (size_t)(BK * 2);
    const size_t hstep = (size_t)HALF * g.ld * 2;
    const size_t tstep = 2 * hstep;
    const unsigned ldsw = (unsigned)wid * 1024u;
    const int aoff = lds_byte(wr * 64 + fr, fq * 8), boff = lds_byte(wc * 32 + fr, fq * 8);
#define PG8_SA(b, h) (((b) * 2 + (h)) * HTB)
#define PG8_SB(b, h) ((4 + (b) * 2 + (h)) * HTB)
#define PG8_STAGE(bufoff, gbase, voff) do { _Pragma("unroll") for (int _i = 0; _i < 2; ++_i) \
        __builtin_amdgcn_global_load_lds((const unsigned*)((const char*)(gbase) + (voff)[_i]), (LAS unsigned*)(lds + (bufoff) + ldsw + _i * 8192), 16, 0, 0); } while (0)
#define PG8_LDA(dst, b, h) do { _Pragma("unroll") for (int m = 0; m < 4; ++m) _Pragma("unroll") for (int k = 0; k < 2; ++k) dst[m][k] = *(const LAS bf16x8*)(lds + PG8_SA(b, h) + aoff + m * 2048 + k * 1024); } while (0)
#define PG8_LDB(dst, b, h) do { _Pragma("unroll") for (int n = 0; n < 2; ++n) _Pragma("unroll") for (int k = 0; k < 2; ++k) dst[n][k] = *(const LAS bf16x8*)(lds + PG8_SB(b, h) + boff + n * 2048 + k * 1024); } while (0)
#define PG8_MMA(ai, bj, At, Bt) do { __builtin_amdgcn_s_setprio(1); _Pragma("unroll") for (int k = 0; k < 2; ++k) _Pragma("unroll") for (int m = 0; m < 4; ++m) _Pragma("unroll") for (int n = 0; n < 2; ++n) \
        acc[ai][bj][m][n] = __builtin_amdgcn_mfma_f32_16x16x32_bf16(Bt[n][k], At[m][k], acc[ai][bj][m][n], 0, 0, 0); __builtin_amdgcn_s_setprio(0); } while (0)
#define PG8_WAIT_V(n) asm volatile("s_waitcnt vmcnt(" #n ")" ::: "memory")
#define PG8_WAIT_L(n) asm volatile("s_waitcnt lgkmcnt(" #n ")" ::: "memory")
#define PG8_BAR __builtin_amdgcn_s_barrier()
#define PG8_SCHED __builtin_amdgcn_sched_barrier(0)
    Unit cur, nxt; int ui = 0;
    if (!S.next(0, cur)) return;
    f32x4 acc[2][2][4][2];
#pragma unroll
    for (int a = 0; a < 2; ++a)
#pragma unroll
        for (int b = 0; b < 2; ++b)
#pragma unroll
            for (int m = 0; m < 4; ++m)
#pragma unroll
                for (int n = 0; n < 2; ++n) acc[a][b][m][n] = (f32x4){0.f, 0.f, 0.f, 0.f};
    bf16x8 At[4][2], B0[2][2], B1[2][2];
    const char* cA = (const char*)g.A + (size_t)cur.pm * tstep + (size_t)cur.kp * K * 2; const char* cB = (const char*)g.Bt + (size_t)cur.pn * tstep + (size_t)cur.kp * K * 2;
    PG8_STAGE(PG8_SB(0, 0), cB, voffB); PG8_STAGE(PG8_SB(0, 1), cB + hstep, voffB); PG8_STAGE(PG8_SA(0, 0), cA, voffA); PG8_STAGE(PG8_SA(0, 1), cA + hstep, voffA);
    if (wr == 1) PG8_BAR;
    PG8_WAIT_V(2); PG8_BAR;
    PG8_STAGE(PG8_SB(1, 0), cB + kstep, voffB); PG8_STAGE(PG8_SA(1, 0), cA + kstep, voffA); PG8_STAGE(PG8_SB(1, 1), cB + hstep + kstep, voffB);
    PG8_WAIT_V(6); PG8_BAR;
    for (;;) {
        const bool has_next = S.next(ui + 1, nxt);
        const char* nA = has_next ? (const char*)g.A + (size_t)nxt.pm * tstep + (size_t)nxt.kp * K * 2 : cA; const char* nB = has_next ? (const char*)g.Bt + (size_t)nxt.pn * tstep + (size_t)nxt.kp * K * 2 : cB;
        for (int t = 0; t < nt; t += 2) {
            const bool last = (t == nt - 2);
            const char* a1 = cA + (size_t)(t + 1) * kstep;
            const char* a2 = last ? nA : cA + (size_t)(t + 2) * kstep; const char* b2 = last ? nB : cB + (size_t)(t + 2) * kstep;
            const char* a3 = a2 + kstep; const char* b3 = b2 + kstep;
            PG8_LDB(B0, 0, 0); PG8_LDB(B1, 0, 1); PG8_SCHED; PG8_LDA(At, 0, 0); PG8_STAGE(PG8_SA(1, 1), a1 + hstep, voffA);
            PG8_WAIT_V(8); PG8_WAIT_L(0); PG8_BAR; PG8_MMA(0, 0, At, B0); PG8_MMA(0, 1, At, B1); PG8_BAR; PG8_SCHED;
            PG8_LDA(At, 0, 1); PG8_STAGE(PG8_SB(0, 0), b2, voffB); PG8_STAGE(PG8_SB(0, 1), b2 + hstep, voffB); PG8_STAGE(PG8_SA(0, 0), a2, voffA);
            PG8_WAIT_V(8); PG8_WAIT_L(0); PG8_BAR; PG8_MMA(1, 0, At, B0); PG8_MMA(1, 1, At, B1); PG8_BAR; PG8_SCHED;
            PG8_LDB(B0, 1, 0); PG8_LDB(B1, 1, 1); PG8_SCHED; PG8_LDA(At, 1, 0); PG8_STAGE(PG8_SA(0, 1), a2 + hstep, voffA);
            PG8_WAIT_V(8); PG8_WAIT_L(0); PG8_BAR; PG8_MMA(0, 0, At, B0); PG8_MMA(0, 1, At, B1); PG8_BAR; PG8_SCHED;
            PG8_LDA(At, 1, 1); PG8_STAGE(PG8_SB(1, 0), b3, voffB); PG8_STAGE(PG8_SB(1, 1), b3 + hstep, voffB); PG8_STAGE(PG8_SA(1, 0), a3, voffA);
            PG8_WAIT_V(8); PG8_WAIT_L(0); PG8_BAR; PG8_MMA(1, 0, At, B0); PG8_MMA(1, 1, At, B1); PG8_BAR; PG8_SCHED;
        }
        if constexpr (ALIGN_EPI) { if (wr == 0) PG8_BAR; }
        E(acc, cur, wr, wc, fr, fq);
        if (!has_next) break;
#pragma unroll
        for (int a = 0; a < 2; ++a)
#pragma unroll
            for (int b = 0; b < 2; ++b)
#pragma unroll
                for (int m = 0; m < 4; ++m)
#pragma unroll
                    for (int n = 0; n < 2; ++n) acc[a][b][m][n] = (f32x4){0.f, 0.f, 0.f, 0.f};
        cur = nxt; cA = nA; cB = nB; ++ui;
        if constexpr (ALIGN_EPI) { if (wr == 1) PG8_BAR; }
    }
    PG8_WAIT_V(0);
    if constexpr (!ALIGN_EPI) { if (wr == 0) PG8_BAR; }
    PG8_BAR;
#undef PG8_SA
#undef PG8_SB
#undef PG8_STAGE
#undef PG8_LDA
#undef PG8_LDB
#undef PG8_MMA
#undef PG8_WAIT_V
#undef PG8_WAIT_L
#undef PG8_BAR
#undef PG8_SCHED
}
}

#define XB_TMO      128
#define XB_XCNT(j)  (256  + 64 * (j))
#define XB_XSUB(j)  (1280 + 64 * (j))
#define XB_XGEN(j)  (2304 + 64 * (j))
#define XB_TOP      3328
#define XB_TOPGEN   3392
#define XCD_BAR_WORDS 3456
#define XB_SPIN_CAP (1u << 18)

__device__ __forceinline__ unsigned xb_ld(unsigned* p)              { return __hip_atomic_load(p, __ATOMIC_RELAXED, __HIP_MEMORY_SCOPE_AGENT); }
__device__ __forceinline__ unsigned xb_add(unsigned* p, unsigned v) { return __hip_atomic_fetch_add(p, v, __ATOMIC_RELAXED, __HIP_MEMORY_SCOPE_AGENT); }
__device__ __forceinline__ unsigned xb_xcc_id() { return (unsigned)__builtin_amdgcn_s_getreg((3 << 11) | 20) & 0xFu; }
#define XB_SPIN(cond, bar) do { unsigned _sp = 0; while (cond) { __builtin_amdgcn_s_sleep(1); \
    if ((++_sp & 255u) == 0u) { if (xb_ld(&(bar)[XB_TMO])) break; if (_sp > XB_SPIN_CAP) { atomicAdd(&(bar)[XB_TMO], 1u); break; } } } } while (0)

struct XcdBarrier {
    unsigned* bar; unsigned x;
    volatile LAS unsigned* st;
};

__device__ __forceinline__ XcdBarrier xcd_barrier_post(unsigned* bar, volatile LAS unsigned* st) {
    XcdBarrier b; b.bar = bar; b.x = xb_xcc_id(); b.st = st;
    if (threadIdx.x == 0) (void)xb_add(&bar[XB_XCNT(b.x)], 1u);
    return b;
}
__device__ __forceinline__ void xcd_barrier_complete(unsigned* bar, unsigned x, unsigned& nloc, unsigned& nx) {
    const unsigned G = gridDim.x * gridDim.y * gridDim.z;
    unsigned sum, cnt, mine, sp = 0u;
    for (;;) {
        sum = 0u; cnt = 0u; mine = 0u;
#pragma unroll
        for (unsigned j = 0; j < 16; ++j) { const unsigned c = xb_ld(&bar[XB_XCNT(j)]); sum += c; cnt += (c > 0u) ? 1u : 0u; mine = (j == x) ? c : mine; }
        if (sum == G) break;
        __builtin_amdgcn_s_sleep(1);
        if ((++sp & 255u) == 0u) { if (xb_ld(&bar[XB_TMO])) break; if (sp > XB_SPIN_CAP) { atomicAdd(&bar[XB_TMO], 1u); break; } }
    }
    nloc = mine > 0u ? mine : 1u; nx = cnt > 0u ? cnt : 1u;
}

__device__ __forceinline__ void xcd_barrier(const XcdBarrier& b) {
    asm volatile("s_waitcnt vmcnt(0)" ::: "memory");
    __syncthreads();
    if (threadIdx.x == 0) {
        unsigned* bar = b.bar;
        __builtin_amdgcn_s_waitcnt(0);
        unsigned nloc = b.st[0], nx = b.st[1];
        if (nloc == 0u) { xcd_barrier_complete(bar, b.x, nloc, nx); b.st[0] = nloc; b.st[1] = nx; }
        const unsigned old = xb_add(&bar[XB_XSUB(b.x)], 1u);
        const unsigned gen = old / nloc;
        if (old + 1u == (gen + 1u) * nloc) {
            __builtin_amdgcn_fence(__ATOMIC_RELEASE, "agent");
            asm volatile("s_waitcnt vmcnt(0)" ::: "memory");
            const unsigned og = xb_add(&bar[XB_TOP], 1u);
            const unsigned tg = og / nx;
            if (og + 1u == (tg + 1u) * nx) xb_add(&bar[XB_TOPGEN], 1u);
            else XB_SPIN(xb_ld(&bar[XB_TOPGEN]) == tg, bar);
            __builtin_amdgcn_fence(__ATOMIC_ACQUIRE, "agent");
            xb_add(&bar[XB_XGEN(b.x)], 1u);
            asm volatile("s_waitcnt vmcnt(0)" ::: "memory");
        } else {
            XB_SPIN(xb_ld(&bar[XB_XGEN(b.x)]) == gen, bar);
            __builtin_amdgcn_fence(__ATOMIC_ACQUIRE, "agent");
            asm volatile("s_waitcnt vmcnt(0)" ::: "memory");
        }
    }
    __syncthreads();
}


template <int MODE, bool COMB, int NR>
__device__ __forceinline__ void ln_rows(const float* const (&sp)[NR], bool zero_src, float* dstf, bf16_t* dstb, f32x2* st, const float* g, const float* b, int lane,
                                        const bf16_t* sb, const float* pg, const float* pb, float scale) {
    f32x4 v[NR][8]; float sm[NR];
#pragma unroll
    for (int i = 0; i < NR; ++i)
#pragma unroll
        for (int j = 0; j < 8; ++j) v[i][j] = zero_src ? (f32x4){0.f, 0.f, 0.f, 0.f} : *(const f32x4*)(sp[i] + 4 * lane + 256 * j);
    if (COMB) {
        u32x2 sv[NR][8]; float ra[NR], rb[NR];
#pragma unroll
        for (int i = 0; i < NR; ++i)
#pragma unroll
            for (int j = 0; j < 8; ++j) sv[i][j] = *(const u32x2*)(sb + (size_t)i * D + 4 * lane + 256 * j);
#pragma unroll
        for (int i = 0; i < NR; ++i) { const f32x2 ms = st[i]; ra[i] = ALPHA * ms.y; rb[i] = -ms.x * ra[i]; }
#pragma unroll
        for (int j = 0; j < 8; ++j) {
            const f32x4 pgv = *(const f32x4*)(pg + 4 * lane + 256 * j), pbv = *(const f32x4*)(pb + 4 * lane + 256 * j) * ALPHA;
#pragma unroll
            for (int i = 0; i < NR; ++i) { const f32x4 s4 = {bf_lo(sv[i][j].x), bf_hi(sv[i][j].x), bf_lo(sv[i][j].y), bf_hi(sv[i][j].y)};
                v[i][j] = (v[i][j] * ra[i] + rb[i]) * pgv + pbv + s4 * scale;
                if (MODE == 0) *(f32x4*)(dstf + (size_t)i * D + 4 * lane + 256 * j) = v[i][j]; }
        }
    }
#pragma unroll
    for (int i = 0; i < NR; ++i) { float s = 0.f;
#pragma unroll
        for (int j = 0; j < 8; ++j) s += (v[i][j].x + v[i][j].y) + (v[i][j].z + v[i][j].w);
        sm[i] = s; }
    if (MODE == 1) {
#pragma unroll
        for (int i = 0; i < NR; ++i)
#pragma unroll
            for (int j = 0; j < 8; ++j) *(f32x4*)(dstf + (size_t)i * D + 4 * lane + 256 * j) = v[i][j];
    }
#pragma unroll
    for (int o = 1; o < 64; o <<= 1) {
#pragma unroll
        for (int i = 0; i < NR; ++i) sm[i] += __shfl_xor(sm[i], o); }
    float mean[NR], q[NR], rstd[NR];
#pragma unroll
    for (int i = 0; i < NR; ++i) { mean[i] = sm[i] * (1.f / D); float s2 = 0.f;
#pragma unroll
        for (int j = 0; j < 8; ++j) { v[i][j] = v[i][j] - mean[i]; s2 += (v[i][j].x * v[i][j].x + v[i][j].y * v[i][j].y) + (v[i][j].z * v[i][j].z + v[i][j].w * v[i][j].w); }
        q[i] = s2; }
#pragma unroll
    for (int o = 1; o < 64; o <<= 1) {
#pragma unroll
        for (int i = 0; i < NR; ++i) q[i] += __shfl_xor(q[i], o); }
#pragma unroll
    for (int i = 0; i < NR; ++i) rstd[i] = rsqrtf(q[i] * (1.f / D) + LN_EPS);
    if (MODE != 2) {
#pragma unroll
        for (int i = 0; i < NR; ++i) if (lane == i) st[i] = (f32x2){mean[i], rstd[i]};
    }
#pragma unroll
    for (int j = 0; j < 8; ++j) {
        const f32x4 gg = *(const f32x4*)(g + 4 * lane + 256 * j), bb = *(const f32x4*)(b + 4 * lane + 256 * j);
#pragma unroll
        for (int i = 0; i < NR; ++i) {
            const f32x4 y = v[i][j] * rstd[i] * gg + bb;
            if (MODE == 2) *(f32x4*)(dstf + (size_t)i * D + 4 * lane + 256 * j) = y;
            else { u32x2 w; w.x = cvt_pk_bf16(y.x, y.y); w.y = cvt_pk_bf16(y.z, y.w); *(u32x2*)(dstb + (size_t)i * D + 4 * lane + 256 * j) = w; }
        }
    }
}

__device__ __forceinline__ void transpose_item(const float* W, int K, int N, bf16_t* WT, int k0, int n0, int drow0, LAS float* scr, int lane) {
    float wv[32];
#pragma unroll
    for (int i = 0; i < 32; ++i) wv[i] = W[(size_t)(k0 + 2 * i + (lane >> 5)) * N + n0 + (lane & 31)];
#pragma unroll
    for (int i = 0; i < 32; ++i) scr[(2 * i + (lane >> 5)) * 33 + (lane & 31)] = wv[i];
    asm volatile("s_waitcnt lgkmcnt(0)" ::: "memory");
    const int c = lane & 7;
#pragma unroll
    for (int j = 0; j < 4; ++j) { const int n = (lane >> 3) + 8 * j; const LAS float* s = scr + (8 * c) * 33 + n;
        u32x4 o; o.x = cvt_pk_bf16(s[0 * 33], s[1 * 33]); o.y = cvt_pk_bf16(s[2 * 33], s[3 * 33]); o.z = cvt_pk_bf16(s[4 * 33], s[5 * 33]); o.w = cvt_pk_bf16(s[6 * 33], s[7 * 33]);
        *(u32x4*)(WT + (size_t)(drow0 + n) * K + k0 + 8 * c) = o; }
    asm volatile("s_waitcnt lgkmcnt(0)" ::: "memory");
}

__device__ __forceinline__ void convert_weights(const Args& a, int l, LAS unsigned char* lds, int part, int b0, int nb) {
    const int tid = ltid(), bid = lbid(), lane = tid & 63, wave = tid >> 6, G = gridDim.x;
    LAS float* scr = (LAS float*)(lds + wave * 8448);
    unsigned char* wb = a.ws + WS_W;
    const int gw = (bid - b0) * 8 + wave, NGW = nb * 8;
    constexpr int I_FF = (D / 64) * (FF / 32);
    constexpr int I_IN = (D / 64) * (DIN / 32);
    constexpr int I_OUT = (1536 / 64) * (D / 32);
    constexpr int NITEMS = 6 * I_FF + I_IN + I_OUT;
    for (int it = gw; it < NITEMS; it += NGW) {
        int r = it;
        if (r < 6 * I_FF) {
            const int which = r / I_FF; r -= which * I_FF;
            if ((which >= 3) != (part == 1)) continue;
            const int f = which / 3, kind = which % 3;
            const float* src = a.in[(f ? 25 : 5) + kind] + (size_t)l * D * FF;
            if (kind < 2) { const int nblk = FF / 32, kb = r / nblk, nb = r % nblk, n0 = nb * 32;
                transpose_item(src, D, FF, (bf16_t*)(wb + (f ? W_GU2 : W_GU1)), kb * 64, n0, (n0 >> 7) * 256 + kind * 128 + (n0 & 127), scr, lane); }
            else { const int nblk = D / 32, kb = r / nblk, nb = r % nblk;
                transpose_item(src, FF, D, (bf16_t*)(wb + (f ? W_D2 : W_D1)), kb * 64, nb * 32, nb * 32, scr, lane); }
            continue;
        }
        r -= 6 * I_FF;
        if (part == 1) break;
        if (r < I_IN) { const int nblk = DIN / 32, kb = r / nblk, nb = r % nblk;
            transpose_item(a.in[10] + (size_t)l * D * DIN, D, DIN, (bf16_t*)(wb + W_IN), kb * 64, nb * 32, nb * 32, scr, lane); continue; }
        r -= I_IN;
        { const int nblk = D / 32, kb = r / nblk, nb = r % nblk;
          transpose_item(a.in[22] + (size_t)l * D * D, D, D, (bf16_t*)(wb + W_OUT), kb * 64, nb * 32, nb * 32, scr, lane); }
    }
    if (part == 0)
    {
        const float* pw = a.in[20] + (size_t)l * 4 * 128 * 128; const float* ps = a.in[21] + (size_t)l * DPOOL; const float* wo = a.in[22] + (size_t)l * D * D;
        bf16_t* WT = (bf16_t*)(wb + W_OUT);
        for (int it = (bid - b0) * 512 + tid; it < 64 * D; it += nb * 512) {
            const int n = it % D, kq = __builtin_amdgcn_readfirstlane(it / D), gq = kq >> 4, i0 = (kq & 15) * 8;
            float accv[8];
#pragma unroll
            for (int e = 0; e < 8; ++e) accv[e] = 0.f;
#pragma unroll 2
            for (int j0 = 0; j0 < 128; j0 += 8) {
                float wv[8];
#pragma unroll
                for (int jj = 0; jj < 8; ++jj) wv[jj] = wo[(size_t)(1536 + gq * 128 + j0 + jj) * D + n] * ps[gq * 128 + j0 + jj];
#pragma unroll
                for (int jj = 0; jj < 8; ++jj)
#pragma unroll
                    for (int e = 0; e < 8; ++e) accv[e] += pw[(gq * 128 + i0 + e) * 128 + j0 + jj] * wv[jj];
            }
            u32x4 o; o.x = cvt_pk_bf16(accv[0], accv[1]); o.y = cvt_pk_bf16(accv[2], accv[3]); o.z = cvt_pk_bf16(accv[4], accv[5]); o.w = cvt_pk_bf16(accv[6], accv[7]);
            *(u32x4*)(WT + (size_t)n * D + 1536 + gq * 128 + i0) = o;
        }
    }
}

__device__ __forceinline__ float* xrow_ptr(const Args& a, int r) { return r < NTOK ? a.out + (size_t)r * D : (float*)(a.ws + WS_XM) + (size_t)(r - NTOK) * D; }

__device__ __forceinline__ void unpack8v(const u32x4 w, f32x4& lo, f32x4& hi) { lo = (f32x4){bf_lo(w.x), bf_hi(w.x), bf_lo(w.y), bf_hi(w.y)}; hi = (f32x4){bf_lo(w.z), bf_hi(w.z), bf_lo(w.w), bf_hi(w.w)}; }
template <int NR>
__device__ __forceinline__ void ln_comb(bf16_t* h, const bf16_t* sb, float scale, const float* g, const float* b, int lane) {
    u32x4 hv[NR][4], sv[NR][4]; f32x4 v[NR][4][2]; float sm[NR];
#pragma unroll
    for (int i = 0; i < NR; ++i)
#pragma unroll
        for (int j = 0; j < 4; ++j) { hv[i][j] = *(const u32x4*)(h + (size_t)i * D + 8 * lane + 512 * j); sv[i][j] = *(const u32x4*)(sb + (size_t)i * D + 8 * lane + 512 * j); }
#pragma unroll
    for (int i = 0; i < NR; ++i) { float s = 0.f;
#pragma unroll
        for (int j = 0; j < 4; ++j) { f32x4 h0, h1, s0, s1; unpack8v(hv[i][j], h0, h1); unpack8v(sv[i][j], s0, s1);
            v[i][j][0] = h0 * ALPHA + s0 * scale; v[i][j][1] = h1 * ALPHA + s1 * scale;
            s += ((v[i][j][0].x + v[i][j][0].y) + (v[i][j][0].z + v[i][j][0].w)) + ((v[i][j][1].x + v[i][j][1].y) + (v[i][j][1].z + v[i][j][1].w)); }
        sm[i] = s; }
#pragma unroll
    for (int o = 1; o < 64; o <<= 1) {
#pragma unroll
        for (int i = 0; i < NR; ++i) sm[i] += __shfl_xor(sm[i], o); }
    float q[NR], rstd[NR];
#pragma unroll
    for (int i = 0; i < NR; ++i) { const float mean = sm[i] * (1.f / D); float s2 = 0.f;
#pragma unroll
        for (int j = 0; j < 4; ++j)
#pragma unroll
            for (int e = 0; e < 2; ++e) { v[i][j][e] = v[i][j][e] - mean; s2 += (v[i][j][e].x * v[i][j][e].x + v[i][j][e].y * v[i][j][e].y) + (v[i][j][e].z * v[i][j][e].z + v[i][j][e].w * v[i][j][e].w); }
        q[i] = s2; }
#pragma unroll
    for (int o = 1; o < 64; o <<= 1) {
#pragma unroll
        for (int i = 0; i < NR; ++i) q[i] += __shfl_xor(q[i], o); }
#pragma unroll
    for (int i = 0; i < NR; ++i) rstd[i] = rsqrtf(q[i] * (1.f / D) + LN_EPS);
#pragma unroll
    for (int j = 0; j < 4; ++j) {
        const int c = 8 * lane + 512 * j;
        const f32x4 g0 = *(const f32x4*)(g + c), g1 = *(const f32x4*)(g + c + 4), b0 = *(const f32x4*)(b + c), b1 = *(const f32x4*)(b + c + 4);
#pragma unroll
        for (int i = 0; i < NR; ++i) { const f32x4 y0 = v[i][j][0] * rstd[i] * g0 + b0, y1 = v[i][j][1] * rstd[i] * g1 + b1;
            u32x4 w; w.x = cvt_pk_bf16(y0.x, y0.y); w.y = cvt_pk_bf16(y0.z, y0.w); w.z = cvt_pk_bf16(y1.x, y1.y); w.w = cvt_pk_bf16(y1.z, y1.w);
            *(u32x4*)(h + (size_t)i * D + c) = w; }
    }
}
template <int NR>
__device__ __forceinline__ void ln_in_rows(const float* const (&sp)[NR], bool zero_src, bf16_t* h, const float* g, const float* b, int lane) {
    f32x4 v[NR][4][2]; float sm[NR];
#pragma unroll
    for (int i = 0; i < NR; ++i)
#pragma unroll
        for (int j = 0; j < 4; ++j)
#pragma unroll
            for (int e = 0; e < 2; ++e) v[i][j][e] = zero_src ? (f32x4){0.f, 0.f, 0.f, 0.f} : *(const f32x4*)(sp[i] + 8 * lane + 512 * j + 4 * e);
#pragma unroll
    for (int i = 0; i < NR; ++i) { float s = 0.f;
#pragma unroll
        for (int j = 0; j < 4; ++j)
#pragma unroll
            for (int e = 0; e < 2; ++e) s += (v[i][j][e].x + v[i][j][e].y) + (v[i][j][e].z + v[i][j][e].w);
        sm[i] = s; }
#pragma unroll
    for (int o = 1; o < 64; o <<= 1) {
#pragma unroll
        for (int i = 0; i < NR; ++i) sm[i] += __shfl_xor(sm[i], o); }
    float q[NR], rstd[NR];
#pragma unroll
    for (int i = 0; i < NR; ++i) { const float mean = sm[i] * (1.f / D); float s2 = 0.f;
#pragma unroll
        for (int j = 0; j < 4; ++j)
#pragma unroll
            for (int e = 0; e < 2; ++e) { v[i][j][e] = v[i][j][e] - mean; s2 += (v[i][j][e].x * v[i][j][e].x + v[i][j][e].y * v[i][j][e].y) + (v[i][j][e].z * v[i][j][e].z + v[i][j][e].w * v[i][j][e].w); }
        q[i] = s2; }
#pragma unroll
    for (int o = 1; o < 64; o <<= 1) {
#pragma unroll
        for (int i = 0; i < NR; ++i) q[i] += __shfl_xor(q[i], o); }
#pragma unroll
    for (int i = 0; i < NR; ++i) rstd[i] = rsqrtf(q[i] * (1.f / D) + LN_EPS);
#pragma unroll
    for (int j = 0; j < 4; ++j) {
        const int c = 8 * lane + 512 * j;
        const f32x4 g0 = *(const f32x4*)(g + c), g1 = *(const f32x4*)(g + c + 4), b0 = *(const f32x4*)(b + c), b1 = *(const f32x4*)(b + c + 4);
#pragma unroll
        for (int i = 0; i < NR; ++i) { const f32x4 y0 = v[i][j][0] * rstd[i] * g0 + b0, y1 = v[i][j][1] * rstd[i] * g1 + b1;
            u32x4 w; w.x = cvt_pk_bf16(y0.x, y0.y); w.y = cvt_pk_bf16(y0.z, y0.w); w.z = cvt_pk_bf16(y1.x, y1.y); w.w = cvt_pk_bf16(y1.z, y1.w);
            *(u32x4*)(h + (size_t)i * D + c) = w; }
    }
}
__device__ __forceinline__ void ln_tail_row(bf16_t* h, const float* part, float scale, const float* g, const float* b, int lane) {
    f32x4 v[8]; float s = 0.f;
#pragma unroll
    for (int j = 0; j < 8; ++j) { const int c = 4 * lane + 256 * j; const u32x2 w = *(const u32x2*)(h + c);
        f32x4 p = *(const f32x4*)(part + c);
#pragma unroll
        for (int q = 1; q < 4; ++q) p = p + *(const f32x4*)(part + (size_t)q * 512 * D + c);
        const f32x4 h4 = {bf_lo(w.x), bf_hi(w.x), bf_lo(w.y), bf_hi(w.y)};
        v[j] = h4 * ALPHA + p * scale; s += (v[j].x + v[j].y) + (v[j].z + v[j].w); }
    const float mean = wave_sum(s) * (1.f / D); float s2 = 0.f;
#pragma unroll
    for (int j = 0; j < 8; ++j) { v[j] = v[j] - mean; s2 += (v[j].x * v[j].x + v[j].y * v[j].y) + (v[j].z * v[j].z + v[j].w * v[j].w); }
    const float rstd = rsqrtf(wave_sum(s2) * (1.f / D) + LN_EPS);
#pragma unroll
    for (int j = 0; j < 8; ++j) { const int c = 4 * lane + 256 * j; const f32x4 y = v[j] * rstd * *(const f32x4*)(g + c) + *(const f32x4*)(b + c);
        u32x2 w; w.x = cvt_pk_bf16(y.x, y.y); w.y = cvt_pk_bf16(y.z, y.w); *(u32x2*)(h + c) = w; }
}
__device__ __forceinline__ const float* in_row(const Args& a, int r) {
    if (r < 32768) return a.in[0] + (size_t)r * D;
    if (r < NTOK) return a.in[1] + (size_t)(r - 32768) * D;
    return a.in[2] + (size_t)((r - NTOK) & 15) * D;
}
__device__ __forceinline__ void ln_in_phase(const Args& a) {
    const int tid = ltid(), lane = tid & 63, gw = lbid() * 8 + (tid >> 6), NGW = gridDim.x * 8;
    bf16_t* hb = (bf16_t*)(a.ws + WS_HB); f32x2* st = (f32x2*)(a.ws + WS_ST);
    for (int r = 4 * gw; r < TP; r += 4 * NGW)
      { const float* const sp[4] = {in_row(a, r), in_row(a, r + 1), in_row(a, r + 2), in_row(a, r + 3)};
        ln_in_rows<4>(sp, r >= TREAL, hb + (size_t)r * D, a.in[3], a.in[4], lane); }
}
__device__ __forceinline__ void tail_fix_row(float* x, const float* part, const f32x2 ms, const float* pg, const float* pb, float scale, int lane) {
    const float ra = ALPHA * ms.y, rb = -ms.x * ra;
#pragma unroll
    for (int j = 0; j < 8; ++j) { const int c = 4 * lane + 256 * j;
        f32x4 p = *(const f32x4*)(part + c);
#pragma unroll
        for (int q = 1; q < 4; ++q) p = p + *(const f32x4*)(part + (size_t)q * 512 * D + c);
        const f32x4 v = *(const f32x4*)(x + c);
        *(f32x4*)(x + c) = (v * ra + rb) * *(const f32x4*)(pg + c) + *(const f32x4*)(pb + c) * ALPHA + p * scale; }
}
template <int MODE>
__device__ __forceinline__ void ln_phase(const Args& a, const float* g, const float* b, int nrows, float scale) {
    const int tid = ltid(), lane = tid & 63, gw = lbid() * 8 + (tid >> 6), NGW = gridDim.x * 8;
    bf16_t* hb = (bf16_t*)(a.ws + WS_HB); f32x2* st = (f32x2*)(a.ws + WS_ST);
    if (MODE == 2) {
        for (int r = 4 * gw; r < NTOK; r += 4 * NGW) { float* x = a.out + (size_t)r * D; const float* const sp[4] = {x, x + D, x + 2 * D, x + 3 * D};
            ln_rows<2, false, 4>(sp, false, x, nullptr, st, g, b, lane, nullptr, nullptr, nullptr, 0.f); }
    } else {
        const bf16_t* sbuf = (const bf16_t*)a.out;
        for (int r = 3 * gw; r < NTOK; r += 3 * NGW) ln_comb<3>(hb + (size_t)r * D, sbuf + (size_t)r * D, scale, g, b, lane);
        for (int r = NTOK + gw; r < nrows; r += NGW) ln_tail_row(hb + (size_t)r * D, (const float*)(a.ws + WS_PART) + (size_t)(r - NTOK) * D, scale, g, b, lane);
    }
}

constexpr int LRU_AS = 272;
constexpr int LRU_FS = 144;
constexpr int LRU_OFF_A = 0, LRU_OFF_HO = 64 * LRU_AS, LRU_OFF_LA = 2 * 64 * LRU_AS, LRU_OFF_LB = LRU_OFF_LA + 64 * LRU_FS * 4;
static_assert(LRU_OFF_LB + 64 * LRU_FS * 4 <= LDS_BYTES, "lru lds");

#define LRU_LOAD_RAW(J0) do { const int jA_ = (J0) + 4 * tg; _Pragma("unroll") for (int q_ = 0; q_ < 7; ++q_) { const int j_ = jA_ - 3 + q_; \
        if (j_ >= 0 && j_ < L) { const int p_ = dir ? (L - 1 - j_) : j_; raw[q_] = *(const u32x4*)(proj + (size_t)row_of(s, p_) * DIN + xcol + cg8); } \
        else raw[q_] = (u32x4){0u, 0u, 0u, 0u}; } } while (0)
#define LRU_CONV() do { _Pragma("unroll") for (int o_ = 0; o_ < 4; ++o_) { float y_[8]; \
        _Pragma("unroll") for (int e_ = 0; e_ < 8; ++e_) y_[e_] = cb[e_]; \
        _Pragma("unroll") for (int k_ = 0; k_ < 4; ++k_) { const u32x4 rw_ = raw[o_ + k_]; const unsigned w4_[4] = {rw_.x, rw_.y, rw_.z, rw_.w}; \
            _Pragma("unroll") for (int e_ = 0; e_ < 4; ++e_) { y_[2 * e_] += cw[k_][2 * e_] * bf_lo(w4_[e_]); y_[2 * e_ + 1] += cw[k_][2 * e_ + 1] * bf_hi(w4_[e_]); } } \
        u32x4 w_; w_.x = cvt_pk_bf16(y_[0], y_[1]); w_.y = cvt_pk_bf16(y_[2], y_[3]); w_.z = cvt_pk_bf16(y_[4], y_[5]); w_.w = cvt_pk_bf16(y_[6], y_[7]); \
        *(LAS u32x4*)(At + (4 * tg + o_) * LRU_AS + cg8 * 2) = w_; } } while (0)

__device__ __forceinline__ void lds_barrier() { asm volatile("s_waitcnt lgkmcnt(0)" ::: "memory"); __builtin_amdgcn_s_barrier(); asm volatile("" ::: "memory"); }
__device__ __forceinline__ void lru_item(const Args& a, int l, int item, LAS unsigned char* lds) {
    const int tid = ltid(), lane = tid & 63, wave = __builtin_amdgcn_readfirstlane(tid >> 6), fr = lane & 15, fq = lane >> 4;
    int s, rem;
    if (item < 64) { s = 16 + (item >> 4); rem = item & 15; } else { s = (item - 64) >> 4; rem = (item - 64) & 15; }
    const int hd = rem >> 1, dir = rem & 1, L = seq_len(s);
    const bf16_t* proj = (const bf16_t*)(a.ws + WS_BIG);
    bf16_t* hfb = (bf16_t*)(a.ws + WS_BIG + BIG_HFB);
    const size_t pbase = (size_t)(l * 2 + dir);
    bf16x8 wfa[4], wfx[4];
    {
        const float* wa = a.in[15] + (pbase * 8 + hd) * 128 * 128; const float* wx = a.in[17] + (pbase * 8 + hd) * 128 * 128;
        const int n = 16 * wave + fr;
#pragma unroll
        for (int ks = 0; ks < 4; ++ks) {
            unsigned pa[4], px[4];
#pragma unroll
            for (int e = 0; e < 4; ++e) { const int k = 32 * ks + 8 * fq + 2 * e;
                pa[e] = cvt_pk_bf16(wa[k * 128 + n], wa[(k + 1) * 128 + n]); px[e] = cvt_pk_bf16(wx[k * 128 + n], wx[(k + 1) * 128 + n]); }
            u32x4 ta = {pa[0], pa[1], pa[2], pa[3]}, tx = {px[0], px[1], px[2], px[3]};
            wfa[ks] = __builtin_bit_cast(bf16x8, ta); wfx[ks] = __builtin_bit_cast(bf16x8, tx);
        }
    }
    const int ecol = 16 * wave + fr;
    const float e_ba = a.in[16][pbase * DLRU + hd * 128 + ecol], e_bx = a.in[18][pbase * DLRU + hd * 128 + ecol];
    const float e_coef = -8.0f * log1pf(expf(-a.in[19][pbase * DLRU + hd * 128 + ecol]));
    const int cg8 = (tid & 15) * 8, tg = (tid >> 4) & 15; const bool cvw = tid >= 256;
    float cw[4][8], cb[8];
    {
        const float* cwp = a.in[13] + pbase * 4 * DLRU + hd * 128 + cg8; const float* cbp = a.in[14] + pbase * DLRU + hd * 128 + cg8;
#pragma unroll
        for (int k = 0; k < 4; ++k)
#pragma unroll
            for (int e = 0; e < 8; ++e) cw[k][e] = cwp[k * DLRU + e];
#pragma unroll
        for (int e = 0; e < 8; ++e) cb[e] = cbp[e];
    }
    const int xcol = 1536 + hd * 128;
    float hstate = 0.f;
    LAS unsigned char* At = lds + LRU_OFF_A; LAS unsigned char* HO = lds + LRU_OFF_HO;
    LAS float* LA = (LAS float*)(lds + LRU_OFF_LA); LAS float* LB = (LAS float*)(lds + LRU_OFF_LB);
    const int ntile = (L + 63) >> 6;
    u32x4 raw[7];
    lds_barrier();
    if (cvw) { LRU_LOAD_RAW(0); LRU_CONV();
    if (ntile > 1) LRU_LOAD_RAW(64); }
    lds_barrier();
    for (int t = 0; t < ntile; ++t) {
        const int j0 = t * 64;
        {
            f32x4 accA[4], accX[4]; bf16x8 af[4][4]; bf16_t xr[4][4];
#pragma unroll
            for (int rb = 0; rb < 4; ++rb)
#pragma unroll
                for (int ks = 0; ks < 4; ++ks) af[rb][ks] = *(const LAS bf16x8*)(At + (16 * rb + fr) * LRU_AS + (32 * ks + 8 * fq) * 2);
#pragma unroll
            for (int rb = 0; rb < 4; ++rb)
#pragma unroll
                for (int j = 0; j < 4; ++j) xr[rb][j] = *(const LAS bf16_t*)(At + (16 * rb + 4 * fq + j) * LRU_AS + ecol * 2);
            __builtin_amdgcn_sched_barrier(0);
#pragma unroll
            for (int rb = 0; rb < 4; ++rb) { accA[rb] = (f32x4){0.f, 0.f, 0.f, 0.f}; accX[rb] = (f32x4){0.f, 0.f, 0.f, 0.f}; }
#pragma unroll
            for (int ks = 0; ks < 4; ++ks)
#pragma unroll
                for (int rb = 0; rb < 4; ++rb) {
                    accA[rb] = __builtin_amdgcn_mfma_f32_16x16x32_bf16(af[rb][ks], wfa[ks], accA[rb], 0, 0, 0);
                    accX[rb] = __builtin_amdgcn_mfma_f32_16x16x32_bf16(af[rb][ks], wfx[ks], accX[rb], 0, 0, 0);
                }
#pragma unroll
            for (int rb = 0; rb < 4; ++rb)
#pragma unroll
                for (int j = 0; j < 4; ++j) {
                    const int tt = 16 * rb + 4 * fq + j;
                    const float xcv = bf1(xr[rb][j]);
                    const float r = fast_sigmoid(accA[rb][j] + e_ba), ig = fast_sigmoid(accX[rb][j] + e_bx);
                    const float la = e_coef * r;
                    const float av = __builtin_amdgcn_exp2f(1.44269504089f * la);
                    const float om = 1.0f - __builtin_amdgcn_exp2f(2.88539008178f * la);
                    const float bv = __builtin_amdgcn_sqrtf(fmaxf(om, 0.f)) * ig * xcv;
                    LA[tt * LRU_FS + ecol] = av; LB[tt * LRU_FS + ecol] = bv;
                }
        }
        lds_barrier();
        if (tid < 128) {
#pragma unroll 1
            for (int t0 = 0; t0 < 64; t0 += 16) {
                float av[16], bv[16];
#pragma unroll
                for (int i = 0; i < 16; ++i) { av[i] = LA[(t0 + i) * LRU_FS + tid]; bv[i] = LB[(t0 + i) * LRU_FS + tid]; }
#pragma unroll
                for (int i = 0; i < 16; ++i) { hstate = av[i] * hstate + bv[i]; av[i] = hstate; }
#pragma unroll
                for (int i = 0; i < 16; ++i) *(LAS bf16_t*)(HO + (t0 + i) * LRU_AS + tid * 2) = (bf16_t)(cvt_pk_bf16(av[i], 0.f) & 0xffffu);
            }
        }
        if (cvw && t + 1 < ntile) { LRU_CONV(); if (t + 2 < ntile) LRU_LOAD_RAW(j0 + 128); }
        lds_barrier();
        {
            const int tt = tid >> 3, part = tid & 7, j = j0 + tt;
            if (j < L) { const int p = dir ? (L - 1 - j) : j;
                const u32x4 v0 = *(const LAS u32x4*)(HO + tt * LRU_AS + part * 32), v1 = *(const LAS u32x4*)(HO + tt * LRU_AS + part * 32 + 16);
                bf16_t* o = hfb + (size_t)row_of(s, p) * D + dir * DLRU + hd * 128 + part * 16;
                *(u32x4*)o = v0; *(u32x4*)(o + 8) = v1; }
        }
    }
}
__device__ __forceinline__ void lru_phase(const Args& a, int l, LAS unsigned char* lds) {
    const int b = lbid(), G = gridDim.x;
    if (G == 256) { lru_item(a, l, b, lds); if (b >= 64 && b < 128) lru_item(a, l, b + 192, lds);
        if (b >= 128) { __syncthreads(); convert_weights(a, l, lds, 1, 128, 128); } }
    else { for (int it = b; it < 320; it += G) lru_item(a, l, it, lds); __syncthreads(); convert_weights(a, l, lds, 1, 0, G); }
}

__device__ __forceinline__ void unpack8(const u32x4 w, float (&f)[8]) { f[0] = bf_lo(w.x); f[1] = bf_hi(w.x); f[2] = bf_lo(w.y); f[3] = bf_hi(w.y); f[4] = bf_lo(w.z); f[5] = bf_hi(w.z); f[6] = bf_lo(w.w); f[7] = bf_hi(w.w); }
__device__ __forceinline__ u32x4 pack8(const float (&y)[8]) { u32x4 w; w.x = cvt_pk_bf16(y[0], y[1]); w.y = cvt_pk_bf16(y[2], y[3]); w.z = cvt_pk_bf16(y[4], y[5]); w.w = cvt_pk_bf16(y[6], y[7]); return w; }
__device__ __forceinline__ void ew_phase(const Args& a, int l, LAS unsigned char* lds) {
    const int tid = ltid(), q = tid & 255, sub = tid >> 8, G = gridDim.x;
    const bf16_t* proj = (const bf16_t*)(a.ws + WS_BIG);
    const bf16_t* hfb = (const bf16_t*)(a.ws + WS_BIG + BIG_HFB);
    bf16_t* cat = (bf16_t*)(a.ws + WS_BIG + BIG_HFB);
    LAS unsigned char* pl = lds + sub * (44 * 1024);
    LAS unsigned char* ul = pl + 23 * 1024;
    constexpr int NCH = 16 * 258 + 4 * 514;
    const int per = (NCH + G - 1) / G, c0 = lbid() * per, c1 = (c0 + per) < NCH ? (c0 + per) : NCH;
    const u32x4 Z4 = {0u, 0u, 0u, 0u};
    for (int cbase = c0; cbase < c1; cbase += 2) {
        const int ch = cbase + sub; const bool act = ch < c1;
        int s = 0, c = 0;
        if (act) { if (ch < 4128) { s = ch / 258; c = ch - s * 258; } else { const int t = ch - 4128; s = t / 514; c = t - s * 514; s += 16; } }
        const int L = seq_len(s), p0 = 8 * c, row0 = row_of(s, p0);
        u32x4 Gw[8], Fw[8], Kw[8];
        if (act && q < 64) {
#pragma unroll
            for (int j = 0; j < 8; ++j) Gw[j] = *(const u32x4*)(proj + (size_t)(row0 + j) * DIN + 8 * q);
        } else if (act && q < 192) {
            const int c8 = 8 * (q - 64);
#pragma unroll
            for (int j = 0; j < 8; ++j) { Gw[j] = *(const u32x4*)(proj + (size_t)(row0 + j) * DIN + 2560 + c8);
                Fw[j] = *(const u32x4*)(hfb + (size_t)(row0 + j) * D + c8); Kw[j] = *(const u32x4*)(hfb + (size_t)(row0 + j) * D + DLRU + c8); }
        }
        if (act) {
#pragma unroll
            for (int i = 0; i < 6; ++i) { const int piece = i * 256 + q;
                if (piece < 23 * 64) { const int rr = piece >> 6, cc = piece & 63, p = p0 - 8 + rr;
                    u32x4 v = Z4;
                    if (p >= 0 && p < L) v = *(const u32x4*)(proj + (size_t)row_of(s, p) * DIN + 3584 + cc * 8);
                    *(LAS u32x4*)(pl + rr * 1024 + cc * 16) = v; } }
#pragma unroll
            for (int i = 0; i < 3; ++i) { const int piece = i * 256 + q;
                if (piece < 10 * 64) { const int rr = piece >> 6, cc = piece & 63, p = p0 - 1 + rr;
                    float u[8];
                    if (p >= 0 && p < L) { const bf16_t* pr = proj + (size_t)row_of(s, p) * DIN + cc * 8; float t0[8], t1[8];
                        unpack8(*(const u32x4*)(pr + 512), t0); unpack8(*(const u32x4*)(pr + 1024), t1);
#pragma unroll
                        for (int e = 0; e < 8; ++e) u[e] = t0[e] * t1[e]; }
                    else {
#pragma unroll
                        for (int e = 0; e < 8; ++e) u[e] = 0.f; }
                    *(LAS f32x4*)(ul + rr * 2048 + cc * 32) = (f32x4){u[0], u[1], u[2], u[3]}; *(LAS f32x4*)(ul + rr * 2048 + cc * 32 + 16) = (f32x4){u[4], u[5], u[6], u[7]}; } }
        }
        asm volatile("s_waitcnt vmcnt(0)" ::: "memory");
        __syncthreads();
        if (act) {
        if (q < 64) {
            const int c8 = 8 * q;
            const float* cwp = a.in[11] + (size_t)l * 3 * DCONV + c8; const float* cbp = a.in[12] + (size_t)l * DCONV + c8;
            float w0[8], w1[8], w2[8], cbv[8];
#pragma unroll
            for (int e = 0; e < 8; ++e) { w0[e] = cwp[e]; w1[e] = cwp[DCONV + e]; w2[e] = cwp[2 * DCONV + e]; cbv[e] = cbp[e]; }
            const LAS unsigned char* uc = ul + q * 32;
            f32x4 ua0 = *(const LAS f32x4*)(uc), ua1 = *(const LAS f32x4*)(uc + 16), ub0 = *(const LAS f32x4*)(uc + 2048), ub1 = *(const LAS f32x4*)(uc + 2048 + 16);
#pragma unroll
            for (int j = 0; j < 8; ++j) {
                const f32x4 uc0 = *(const LAS f32x4*)(uc + (j + 2) * 2048), uc1 = *(const LAS f32x4*)(uc + (j + 2) * 2048 + 16);
                float Bg[8], y[8]; unpack8(Gw[j], Bg);
#pragma unroll
                for (int e = 0; e < 4; ++e) { y[e] = Bg[e] * (cbv[e] + w0[e] * ua0[e] + w1[e] * ub0[e] + w2[e] * uc0[e]);
                    y[4 + e] = Bg[4 + e] * (cbv[4 + e] + w0[4 + e] * ua1[e] + w1[4 + e] * ub1[e] + w2[4 + e] * uc1[e]); }
                *(u32x4*)(cat + (size_t)(row0 + j) * D + c8) = pack8(y);
                ua0 = ub0; ua1 = ub1; ub0 = uc0; ub1 = uc1;
            }
        } else if (q < 192) {
            const int c8 = 8 * (q - 64);
#pragma unroll
            for (int j = 0; j < 8; ++j) {
                float gt[8], hf[8], hb[8], y[8];
                unpack8(Gw[j], gt); unpack8(Fw[j], hf); unpack8(Kw[j], hb);
#pragma unroll
                for (int e = 0; e < 8; ++e) { const float x = gt[e]; const float z = 1.5957691216f * (x + 0.044715f * x * x * x); y[e] = x * fast_sigmoid(z) * (hf[e] + hb[e]); }
                *(u32x4*)(cat + (size_t)(row0 + j) * D + 512 + c8) = pack8(y);
            }
        } else {
            const int c8 = 8 * (q - 192), gq = c8 >> 7, hw = 1 << gq;
            const LAS unsigned char* pc = pl + c8 * 2;
            float sm[8], t0[8];
#pragma unroll
            for (int e = 0; e < 8; ++e) sm[e] = 0.f;
#pragma unroll
            for (int dd = -8; dd < 8; ++dd) { const float msk = (dd >= -hw && dd < hw) ? 1.0f : 0.0f;
                unpack8(*(const LAS u32x4*)(pc + (8 + dd) * 1024), t0);
#pragma unroll
                for (int e = 0; e < 8; ++e) sm[e] += msk * t0[e]; }
#pragma unroll
            for (int j = 0; j < 8; ++j) {
                const int p = p0 + j;
                const int lo = (p - hw) > 0 ? (p - hw) : 0, hi = (p + hw - 1) < (L - 1) ? (p + hw - 1) : (L - 1);
                const float inv = 1.0f / (float)(hi - lo + 1);
                float y[8];
                unpack8(*(const LAS u32x4*)(pc + (8 + j) * 1024), t0);
#pragma unroll
                for (int e = 0; e < 8; ++e) y[e] = sm[e] * inv - t0[e];
                *(u32x4*)(cat + (size_t)(row0 + j) * D + 1536 + c8) = pack8(y);
                if (j < 7) {
                    float t1[8];
                    unpack8(*(const LAS u32x4*)(pc + (8 + j - hw) * 1024), t0); unpack8(*(const LAS u32x4*)(pc + (8 + j + hw) * 1024), t1);
#pragma unroll
                    for (int e = 0; e < 8; ++e) sm[e] += t1[e] - t0[e];
                }
            }
        }
        }
        __syncthreads();
    }
}

__device__ __forceinline__ void fill_gb(LAS unsigned char* lds, const float* g, const float* b) {
    const int tid = ltid(); LAS float* gb = (LAS float*)(lds + LDS_GB);
    *(LAS f32x4*)(gb + 4 * tid) = *(const f32x4*)(g + 4 * tid); *(LAS f32x4*)(gb + D + 4 * tid) = *(const f32x4*)(b + 4 * tid) * ALPHA;
    __syncthreads();
}
constexpr int NPHASE = 1 + 11 * DEPTH;
__global__ void __launch_bounds__(512, 2) fwd_megakernel(Args a) {
    extern __shared__ __attribute__((aligned(16))) unsigned char shm[];
    LAS unsigned char* lds = (LAS unsigned char*)shm;
    const int G = gridDim.x;
    bf16_t* hb = (bf16_t*)(a.ws + WS_HB);
    bf16_t* big = (bf16_t*)(a.ws + WS_BIG);
    unsigned char* wb = a.ws + WS_W;
    float* xm = (float*)(a.ws + WS_XM);
    volatile LAS unsigned* misc = (volatile LAS unsigned*)(lds + LDS_GB + 16384);
    if (threadIdx.x < 4) misc[threadIdx.x] = 0u;
    __syncthreads();
    const XcdBarrier bar = xcd_barrier_post((unsigned*)(a.ws + WS_BAR), misc);
    for (int ph = a.ph_lo; ph < a.ph_hi; ++ph) {
        if (ph == a.ph_lo + 1) cg::this_grid().sync();
        else if (ph > a.ph_lo) xcd_barrier(bar);
        if (ph == 0) { for (int rep = 0; rep < (((PROBE_REP >> 11) & 1) ? 2 : 1); ++rep) { convert_weights(a, 0, lds, 0, 0, G); ln_in_phase(a); } continue; }
        const int l = (ph - 1) / 11, k = (ph - 1) % 11;
        for (int rep = 0; rep < (((PROBE_REP >> k) & 1) ? 2 : 1); ++rep) {
        const bool lastl = (l == DEPTH - 1);
        pg8::StaticOrder S;
        switch (k) {
        case 0: case 8: {
            const int M = (k == 8 && lastl) ? NTOK : TP;
            pg8::Gemm g{hb, (const bf16_t*)(wb + (k == 0 ? W_GU1 : W_GU2)), M, 2 * FF, D, D}; S.init(M, 2 * FF, G, lbid());
            pg8::EpiSwiGLU E{big, FF};
            pg8::gemm_phase<pg8::EpiSwiGLU>(lds, g, S, E);
        } break;
        case 1: case 9: {
            pg8::Gemm g{big, (const bf16_t*)(wb + (k == 1 ? W_D1 : W_D2)), NTOK, D, FF, FF}; S.init(NTOK, D, G, lbid());
            const float* lg = (k == 1) ? (l == 0 ? a.in[3] : a.in[28] + (l - 1) * D) : a.in[23] + l * D;
            const float* lb = (k == 1) ? (l == 0 ? a.in[4] : a.in[29] + (l - 1) * D) : a.in[24] + l * D;
            if (k == 9 && lastl) { pg8::EpiZ EZ{a.out, hb}; pg8::gemm_phase<pg8::EpiZ>(lds, g, S, EZ); }
            else { pg8::EpiBf16 E{(bf16_t*)a.out, D}; pg8::gemm_phase<pg8::EpiBf16>(lds, g, S, E); }
            if (!(k == 9 && lastl)) {
                pg8::Gemm gt{big, (const bf16_t*)(wb + (k == 1 ? W_D1 : W_D2)), TP, D, FF / 4, FF}; pg8::TailOrder T{G, lbid()};
                pg8::EpiPartial EP{(float*)(a.ws + WS_PART)};
                pg8::gemm_phase<pg8::EpiPartial, pg8::TailOrder>(lds, gt, T, EP);
            }
        } break;
        case 2: ln_phase<0>(a, a.in[8] + l * D, a.in[9] + l * D, TP, 0.5f); break;
        case 3: {
            pg8::Gemm g{hb, (const bf16_t*)(wb + W_IN), TP, DIN, D, D}; S.init(TP, DIN, G, lbid());
            pg8::EpiBf16 E{big, DIN};
            pg8::gemm_phase<pg8::EpiBf16>(lds, g, S, E);
        } break;
#ifndef PHM
#define PHM 0xfff
#endif
        case 4: if (PHM & 16) lru_phase(a, l, lds); break;
        case 5: if (PHM & 32) ew_phase(a, l, lds); break;
        case 6: {
            const bf16_t* cat = (const bf16_t*)(a.ws + WS_BIG + BIG_HFB);
            pg8::Gemm g{cat, (const bf16_t*)(wb + W_OUT), NTOK, D, D, D}; S.init(NTOK, D, G, lbid());
            pg8::EpiBf16 E{(bf16_t*)a.out, D};
            pg8::gemm_phase<pg8::EpiBf16>(lds, g, S, E);
            if (!lastl) {
                pg8::Gemm gt{cat, (const bf16_t*)(wb + W_OUT), TP, D, D / 4, D}; pg8::TailOrder T{G, lbid()};
                pg8::EpiPartial EP{(float*)(a.ws + WS_PART)};
                pg8::gemm_phase<pg8::EpiPartial, pg8::TailOrder>(lds, gt, T, EP);
            }
        } break;
        case 7: ln_phase<0>(a, a.in[23] + l * D, a.in[24] + l * D, lastl ? NTOK : TP, 1.0f); break;
        default: {
            if (lastl) ln_phase<2>(a, a.in[28] + l * D, a.in[29] + l * D, NTOK, 0.f);
            else { ln_phase<0>(a, a.in[28] + l * D, a.in[29] + l * D, TP, 0.5f); convert_weights(a, l + 1, lds, 0, 0, G); }
        } break;
        }
        }
    }
}

extern "C" void kernel_launch(void* const* d_in, const int* in_sizes, int n_in, void* d_out, int out_size, void* d_ws, size_t ws_size, hipStream_t stream) {
    static int grid = 0;
    if (grid == 0) {
        int dev = 0, cus = 0, per_cu = 0;
        if (n_in != 30 || out_size != NTOK * D || ws_size < WS_TOTAL) { fprintf(stderr, "kernel_launch: unexpected shapes (n_in %d out %d ws %zu need %zu)\n", n_in, out_size, ws_size, (size_t)WS_END); }
        hipGetDevice(&dev);
        hipDeviceGetAttribute(&cus, hipDeviceAttributeMultiprocessorCount, dev);
        hipFuncSetAttribute((const void*)fwd_megakernel, hipFuncAttributeMaxDynamicSharedMemorySize, LDS_BYTES);
        hipOccupancyMaxActiveBlocksPerMultiprocessor(&per_cu, (const void*)fwd_megakernel, 512, LDS_BYTES);
        if (per_cu < 1) { fprintf(stderr, "kernel_launch: occupancy query says %d blocks per CU\n", per_cu); per_cu = 1; }
        (void)hipGetLastError();
        grid = cus * 1;
        fprintf(stderr, "kernel_launch: grid %d (per_cu %d)\n", grid, per_cu);
    }
    hipMemsetAsync((char*)d_ws + WS_BAR, 0, 16384, stream);
    Args a{};
    for (int i = 0; i < 30; ++i) a.in[i] = (const float*)d_in[i];
    a.out = (float*)d_out; a.ws = (unsigned char*)d_ws;
#if MK_MULTI
    for (int ph = 0; ph < NPHASE; ++ph) {
        a.ph_lo = ph; a.ph_hi = ph + 1;
        hipLaunchKernelGGL(fwd_megakernel, dim3(grid), dim3(512), LDS_BYTES, stream, a);
    }
#else
    a.ph_lo = 0; a.ph_hi = NPHASE;
    void* params[] = {&a};
    hipError_t e = hipLaunchCooperativeKernel((const void*)fwd_megakernel, dim3(grid), dim3(512), params, LDS_BYTES, stream);
    if (e != hipSuccess) fprintf(stderr, "cooperative launch failed: %s (grid %d)\n", hipGetErrorString(e), grid);
#endif
}
```

```cpp
#include <hip/hip_runtime.h>
#include <hip/hip_cooperative_groups.h>
#include <cstdio>
#include <cstdint>
namespace cg = cooperative_groups;

#ifndef MK_MULTI
#define MK_MULTI 0
#endif

#ifndef PROBE_REP
#define PROBE_REP 0
#endif
#define LAS __attribute__((address_space(3)))
typedef unsigned short bf16_t;
typedef short bf16x8 __attribute__((ext_vector_type(8)));
typedef float f32x4 __attribute__((ext_vector_type(4)));
typedef float f32x2 __attribute__((ext_vector_type(2)));
typedef unsigned u32x4 __attribute__((ext_vector_type(4)));
typedef unsigned u32x2 __attribute__((ext_vector_type(2)));

constexpr int D = 2048, FF = 5632, DIN = 4096, DEPTH = 2;
constexpr int NTOK = 49152;
constexpr int NMETA = 16, NSEQ = 20;
constexpr int TREAL = NTOK + NSEQ * NMETA;
constexpr int TP = 49664;
constexpr int DLRU = 1024, DCONV = 512, DPOOL = 512;
constexpr float ALPHA = 1.41421356237f;
constexpr float LN_EPS = 1e-5f;
constexpr int LDS_BYTES = 131072 + 16384 + 16;
constexpr int LDS_GB = 131072;

constexpr size_t WS_HB = 0;
constexpr size_t WS_XM = WS_HB + (size_t)TP * D * 2;
constexpr size_t WS_ST = WS_XM + (size_t)512 * D * 4;
constexpr size_t WS_BAR = WS_ST + (size_t)TP * 8;
constexpr size_t WS_W = WS_BAR + 16384;
constexpr size_t W_GU1 = 0, W_D1 = W_GU1 + (size_t)2 * FF * D * 2, W_GU2 = W_D1 + (size_t)D * FF * 2, W_D2 = W_GU2 + (size_t)2 * FF * D * 2,
                 W_IN = W_D2 + (size_t)D * FF * 2, W_OUT = W_IN + (size_t)DIN * D * 2, W_END = W_OUT + (size_t)D * D * 2;
constexpr size_t WS_BIG = WS_W + W_END;
constexpr size_t BIG_HFB = (size_t)TP * DIN * 2;
constexpr size_t WS_END = WS_BIG + (size_t)TP * DIN * 2 + (size_t)TP * D * 2;
constexpr size_t WS_PART = WS_END;
constexpr size_t WS_TOTAL = WS_PART + (size_t)4 * 512 * D * 4;
static_assert((size_t)TP * FF * 2 <= (size_t)TP * DIN * 2 + (size_t)TP * D * 2, "hidden fits");

struct Args { const float* in[30]; float* out; unsigned char* ws; int ph_lo, ph_hi; };

__device__ __forceinline__ unsigned cvt_pk_bf16(float lo, float hi) { unsigned r; asm volatile("v_cvt_pk_bf16_f32 %0, %1, %2" : "=v"(r) : "v"(lo), "v"(hi)); return r; }
__device__ __forceinline__ float bf_lo(unsigned w) { return __uint_as_float(w << 16); }
__device__ __forceinline__ float bf_hi(unsigned w) { return __uint_as_float(w & 0xffff0000u); }
__device__ __forceinline__ float bf1(bf16_t h) { return __uint_as_float(((unsigned)h) << 16); }
__device__ __forceinline__ float fast_sigmoid(float x) { return __builtin_amdgcn_rcpf(1.0f + __builtin_amdgcn_exp2f(-1.44269504089f * x)); }
__device__ __forceinline__ float wave_sum(float v) {
#pragma unroll
    for (int o = 1; o < 64; o <<= 1) v += __shfl_xor(v, o);
    return v;
}
__device__ __forceinline__ int ltid() { int t = threadIdx.x; asm volatile("" : "+v"(t)); return t; }
__device__ __forceinline__ int lbid() { int b = blockIdx.x; asm volatile("" : "+s"(b)); return b; }
__device__ __forceinline__ int seq_len(int s) { return s < 16 ? 2064 : 4112; }
__device__ __forceinline__ int row_of(int s, int p) {
    if (p < NMETA) return NTOK + s * NMETA + p;
    return (s < 16 ? s * 2048 : 32768 + (s - 16) * 4096) + (p - NMETA);
}

namespace pg8 {
constexpr int BM = 256, BK = 64, HALF = 128, HTB = HALF * BK * 2, STAGE_BYTES = 8 * HTB, NXCD = 8, WGM = 4;
__host__ __device__ __forceinline__ int lds_byte(int r, int c) { const int st = (r >> 4) * 2 + (c >> 5), rr = r & 15, cc = c & 31, ob = rr * 64 + cc * 2; return st * 1024 + (ob ^ (((ob >> 9) & 1) << 5)); }
__host__ __device__ __forceinline__ void stage_rc(int b, int& R, int& C) { const int st = b / 1024, sb = b % 1024, swz = sb ^ (((sb >> 9) & 1) << 5); R = (st >> 1) * 16 + swz / 64; C = (st & 1) * 32 + (swz % 64) / 2; }
__host__ __device__ __forceinline__ int perm32(int rho) { const int n = rho >> 4, i = rho & 15; return 8 * (i >> 2) + 4 * n + (i & 3); }

struct Unit { int pm, pn, kp; };
struct Gemm { const bf16_t* A; const bf16_t* Bt; int M, N, K, ld; };

struct StaticOrder {
    int nM, nN, nwg, G, c;
    __device__ void init(int M, int N, int G_, int c_) { nM = M / BM; nN = N / BM; nwg = nM * nN; G = G_; c = c_; }
    __device__ bool next(int i, Unit& u) const {
        const long L = (long)i * G + c; if (L >= nwg) return false;
        int wgid = (int)L; { const int q = nwg / NXCD, r = nwg % NXCD, xcd = wgid % NXCD, off = wgid / NXCD; wgid = (xcd < r ? xcd * (q + 1) : r * (q + 1) + (xcd - r) * q) + off; }
        const int nig = WGM * nN, gid = wgid / nig, fm = gid * WGM, gsz = (nM - fm) < WGM ? (nM - fm) : WGM;
        u.pm = fm + ((wgid % nig) % gsz); u.pn = (wgid % nig) / gsz; u.kp = 0; return true;
    }
};

struct TailOrder {
    int G, c;
    __device__ bool next(int i, Unit& u) const { const int idx = i * G + c; if (idx >= 64) return false; u.kp = idx & 3; u.pn = (idx >> 2) & 7; u.pm = 192 + (idx >> 5); return true; }
};

struct EpiBf16 {
    static constexpr bool PERM = true;
    bf16_t* O; int ldc;
    __device__ __forceinline__ void operator()(const f32x4 (&acc)[2][2][4][2], const Unit& u, int wr, int wc, int fr, int fq) const {
        const int row0 = u.pm * BM + wr * 64 + fr, col0 = u.pn * BM + wc * 32 + 8 * fq;
#pragma unroll
        for (int ai = 0; ai < 2; ++ai)
#pragma unroll
            for (int m = 0; m < 4; ++m) { bf16_t* rowp = O + (size_t)(row0 + ai * HALF + m * 16) * ldc + col0;
#pragma unroll
                for (int bj = 0; bj < 2; ++bj) { const f32x4 v0 = acc[ai][bj][m][0], v1 = acc[ai][bj][m][1];
                    u32x4 w; w.x = cvt_pk_bf16(v0[0], v0[1]); w.y = cvt_pk_bf16(v0[2], v0[3]); w.z = cvt_pk_bf16(v1[0], v1[1]); w.w = cvt_pk_bf16(v1[2], v1[3]);
                    *(u32x4*)(rowp + bj * HALF) = w; } }
    }
};
struct EpiSwiGLU {
    static constexpr bool PERM = true;
    bf16_t* O; int ldc;
    __device__ __forceinline__ void operator()(const f32x4 (&acc)[2][2][4][2], const Unit& u, int wr, int wc, int fr, int fq) const {
        const int row0 = u.pm * BM + wr * 64 + fr, col0 = u.pn * HALF + wc * 32 + 8 * fq;
#pragma unroll
        for (int ai = 0; ai < 2; ++ai)
#pragma unroll
            for (int m = 0; m < 4; ++m) { bf16_t* rowp = O + (size_t)(row0 + ai * HALF + m * 16) * ldc + col0;
                float h[8];
#pragma unroll
                for (int n = 0; n < 2; ++n)
#pragma unroll
                    for (int j = 0; j < 4; ++j) { const float g = acc[ai][0][m][n][j], up = acc[ai][1][m][n][j]; h[n * 4 + j] = g * fast_sigmoid(g) * up; }
                u32x4 w; w.x = cvt_pk_bf16(h[0], h[1]); w.y = cvt_pk_bf16(h[2], h[3]); w.z = cvt_pk_bf16(h[4], h[5]); w.w = cvt_pk_bf16(h[6], h[7]);
                *(u32x4*)rowp = w; }
    }
};
struct EpiResid {
    static constexpr bool PERM = false;
    float* X0; float* X1; int split; float alpha, scale; const f32x2* st; const LAS float* gb;
    __device__ __forceinline__ void operator()(const f32x4 (&acc)[2][2][4][2], const Unit& u, int wr, int wc, int fr, int fq) const {
        float* base = (u.pm < split) ? X0 + (size_t)u.pm * BM * D : X1 + (size_t)(u.pm - split) * BM * D;
        const int row0 = wr * 64 + fr, col0 = u.pn * BM + wc * 32 + 4 * fq;
        float ra[2][4], rb[2][4];
#pragma unroll
        for (int ai = 0; ai < 2; ++ai)
#pragma unroll
            for (int m = 0; m < 4; ++m) { const f32x2 ms = st[u.pm * BM + row0 + ai * HALF + m * 16]; ra[ai][m] = alpha * ms.y; rb[ai][m] = -ms.x * ra[ai][m]; }
#pragma unroll
        for (int ai = 0; ai < 2; ++ai) {
            asm volatile("" ::: "memory");
#pragma unroll
            for (int m = 0; m < 4; ++m) { float* rowp = base + (size_t)(row0 + ai * HALF + m * 16) * D + col0;
#pragma unroll
                for (int bj = 0; bj < 2; ++bj)
#pragma unroll
                    for (int n = 0; n < 2; ++n) { f32x4* p = (f32x4*)(rowp + bj * HALF + n * 16); const f32x4 x = *p;
                        const f32x4 gv = *(const LAS f32x4*)(gb + col0 + bj * HALF + n * 16), bv = *(const LAS f32x4*)(gb + D + col0 + bj * HALF + n * 16);
                        *p = (x * ra[ai][m] + rb[ai][m]) * gv + bv + acc[ai][bj][m][n] * scale; } }
        }
    }
};

struct EpiZ {
    static constexpr bool PERM = false;
    float* Z; const bf16_t* H;
    __device__ __forceinline__ void operator()(const f32x4 (&acc)[2][2][4][2], const Unit& u, int wr, int wc, int fr, int fq) const {
        const size_t off0 = (size_t)(u.pm * BM + wr * 64 + fr) * D + u.pn * BM + wc * 32 + 4 * fq;
#pragma unroll
        for (int ai = 0; ai < 2; ++ai) {
            u32x2 hv[4][2][2];
#pragma unroll
            for (int m = 0; m < 4; ++m)
#pragma unroll
                for (int bj = 0; bj < 2; ++bj)
#pragma unroll
                    for (int n = 0; n < 2; ++n) hv[m][bj][n] = *(const u32x2*)(H + off0 + (size_t)(ai * HALF + m * 16) * D + bj * HALF + n * 16);
#pragma unroll
            for (int m = 0; m < 4; ++m)
#pragma unroll
                for (int bj = 0; bj < 2; ++bj)
#pragma unroll
                    for (int n = 0; n < 2; ++n) { const u32x2 w = hv[m][bj][n]; const f32x4 h4 = {bf_lo(w.x), bf_hi(w.x), bf_lo(w.y), bf_hi(w.y)};
                        *(f32x4*)(Z + off0 + (size_t)(ai * HALF + m * 16) * D + bj * HALF + n * 16) = h4 * ALPHA + acc[ai][bj][m][n] * 0.5f; }
        }
    }
};
struct EpiPartial {
    static constexpr bool PERM = false;
    float* P;
    __device__ __forceinline__ void operator()(const f32x4 (&acc)[2][2][4][2], const Unit& u, int wr, int wc, int fr, int fq) const {
        float* base = P + ((size_t)u.kp * 512 + (size_t)(u.pm - NTOK / BM) * BM + wr * 64 + fr) * D + u.pn * BM + wc * 32 + 4 * fq;
#pragma unroll
        for (int ai = 0; ai < 2; ++ai)
#pragma unroll
            for (int m = 0; m < 4; ++m)
#pragma unroll
                for (int bj = 0; bj < 2; ++bj)
#pragma unroll
                    for (int n = 0; n < 2; ++n) *(f32x4*)(base + (size_t)(ai * HALF + m * 16) * D + bj * HALF + n * 16) = acc[ai][bj][m][n];
    }
};

template <class Epi, class Sched = StaticOrder, bool ALIGN_EPI = true>
__device__ __forceinline__ void gemm_phase(LAS unsigned char* lds, const Gemm g, const Sched& S, const Epi& E) {
    const int tid = ltid(), wid = __builtin_amdgcn_readfirstlane(tid >> 6), lane = tid & 63, wr = wid >> 2, wc = wid & 3, fr = lane & 15, fq = lane >> 4;
    const int K = g.K, nt = K / BK;
    unsigned voffA[2], voffB[2];
#pragma unroll
    for (int i = 0; i < 2; ++i) { int R, C; stage_rc(tid * 16 + i * 8192, R, C); const int Rb = Epi::PERM ? ((R & ~31) + perm32(R & 31)) : R;
        voffA[i] = (unsigned)(R * g.ld + C) * 2u; voffB[i] = (unsigned)(Rb * g.ld + C) * 2u; }
    const size_t kstep = (size_t)(BK * 2);
    const size_t hstep = (size_t)HALF * g.ld * 2;
    const size_t tstep = 2 * hstep;
    const unsigned ldsw = (unsigned)wid * 1024u;
    const int aoff = lds_byte(wr * 64 + fr, fq * 8), boff = lds_byte(wc * 32 + fr, fq * 8);
#define PG8_SA(b, h) (((b) * 2 + (h)) * HTB)
#define PG8_SB(b, h) ((4 + (b) * 2 + (h)) * HTB)
#define PG8_STAGE(bufoff, gbase, voff) do { _Pragma("unroll") for (int _i = 0; _i < 2; ++_i) \
        __builtin_amdgcn_global_load_lds((const unsigned*)((const char*)(gbase) + (voff)[_i]), (LAS unsigned*)(lds + (bufoff) + ldsw + _i * 8192), 16, 0, 0); } while (0)
#define PG8_LDA(dst, b, h) do { _Pragma("unroll") for (int m = 0; m < 4; ++m) _Pragma("unroll") for (int k = 0; k < 2; ++k) dst[m][k] = *(const LAS bf16x8*)(lds + PG8_SA(b, h) + aoff + m * 2048 + k * 1024); } while (0)
#define PG8_LDB(dst, b, h) do { _Pragma("unroll") for (int n = 0; n < 2; ++n) _Pragma("unroll") for (int k = 0; k < 2; ++k) dst[n][k] = *(const LAS bf16x8*)(lds + PG8_SB(b, h) + boff + n * 2048 + k * 1024); } while (0)
#define PG8_MMA(ai, bj, At, Bt) do { __builtin_amdgcn_s_setprio(1); _Pragma("unroll") for (int m = 0; m < 4; ++m) _Pragma("unroll") for (int n = 0; n < 2; ++n) _Pragma("unroll") for (int k = 0; k < 2; ++k) \
        acc[ai][bj][m][n] = __builtin_amdgcn_mfma_f32_16x16x32_bf16(Bt[n][k], At[m][k], acc[ai][bj][m][n], 0, 0, 0); __builtin_amdgcn_s_setprio(0); } while (0)
#define PG8_WAIT_V(n) asm volatile("s_waitcnt vmcnt(" #n ")" ::: "memory")
#define PG8_WAIT_L(n) asm volatile("s_waitcnt lgkmcnt(" #n ")" ::: "memory")
#define PG8_BAR __builtin_amdgcn_s_barrier()
#define PG8_SCHED __builtin_amdgcn_sched_barrier(0)
    Unit cur, nxt; int ui = 0;
    if (!S.next(0, cur)) return;
    f32x4 acc[2][2][4][2];
#pragma unroll
    for (int a = 0; a < 2; ++a)
#pragma unroll
        for (int b = 0; b < 2; ++b)
#pragma unroll
            for (int m = 0; m < 4; ++m)
#pragma unroll
                for (int n = 0; n < 2; ++n) acc[a][b][m][n] = (f32x4){0.f, 0.f, 0.f, 0.f};
    bf16x8 At[4][2], B0[2][2], B1[2][2];
    const char* cA = (const char*)g.A + (size_t)cur.pm * tstep + (size_t)cur.kp * K * 2; const char* cB = (const char*)g.Bt + (size_t)cur.pn * tstep + (size_t)cur.kp * K * 2;
    PG8_STAGE(PG8_SB(0, 0), cB, voffB); PG8_STAGE(PG8_SB(0, 1), cB + hstep, voffB); PG8_STAGE(PG8_SA(0, 0), cA, voffA); PG8_STAGE(PG8_SA(0, 1), cA + hstep, voffA);
    if (wr == 1) PG8_BAR;
    PG8_WAIT_V(2); PG8_BAR;
    PG8_STAGE(PG8_SB(1, 0), cB + kstep, voffB); PG8_STAGE(PG8_SA(1, 0), cA + kstep, voffA); PG8_STAGE(PG8_SB(1, 1), cB + hstep + kstep, voffB);
    PG8_WAIT_V(6); PG8_BAR;
    for (;;) {
        const bool has_next = S.next(ui + 1, nxt);
        const char* nA = has_next ? (const char*)g.A + (size_t)nxt.pm * tstep + (size_t)nxt.kp * K * 2 : cA; const char* nB = has_next ? (const char*)g.Bt + (size_t)nxt.pn * tstep + (size_t)nxt.kp * K * 2 : cB;
        for (int t = 0; t < nt; t += 2) {
            const bool last = (t == nt - 2);
            const char* a1 = cA + (size_t)(t + 1) * kstep;
            const char* a2 = last ? nA : cA + (size_t)(t + 2) * kstep; const char* b2 = last ? nB : cB + (size_t)(t + 2) * kstep;
            const char* a3 = a2 + kstep; const char* b3 = b2 + kstep;
            PG8_LDB(B0, 0, 0); PG8_LDB(B1, 0, 1); PG8_SCHED; PG8_LDA(At, 0, 0); PG8_STAGE(PG8_SA(1, 1), a1 + hstep, voffA);
            PG8_WAIT_V(8); PG8_WAIT_L(0); PG8_BAR; PG8_MMA(0, 0, At, B0); PG8_MMA(0, 1, At, B1); PG8_BAR; PG8_SCHED;
            PG8_LDA(At, 0, 1); PG8_STAGE(PG8_SB(0, 0), b2, voffB); PG8_STAGE(PG8_SB(0, 1), b2 + hstep, voffB); PG8_STAGE(PG8_SA(0, 0), a2, voffA);
            PG8_WAIT_V(8); PG8_WAIT_L(0); PG8_BAR; PG8_MMA(1, 0, At, B0); PG8_MMA(1, 1, At, B1); PG8_BAR; PG8_SCHED;
            PG8_LDB(B0, 1, 0); PG8_LDB(B1, 1, 1); PG8_SCHED; PG8_LDA(At, 1, 0); PG8_STAGE(PG8_SA(0, 1), a2 + hstep, voffA);
            PG8_WAIT_V(8); PG8_WAIT_L(0); PG8_BAR; PG8_MMA(0, 0, At, B0); PG8_MMA(0, 1, At, B1); PG8_BAR; PG8_SCHED;
            PG8_LDA(At, 1, 1); PG8_STAGE(PG8_SB(1, 0), b3, voffB); PG8_STAGE(PG8_SB(1, 1), b3 + hstep, voffB); PG8_STAGE(PG8_SA(1, 0), a3, voffA);
            PG8_WAIT_V(8); PG8_WAIT_L(0); PG8_BAR; PG8_MMA(1, 0, At, B0); PG8_MMA(1, 1, At, B1); PG8_BAR; PG8_SCHED;
        }
        if constexpr (ALIGN_EPI) { if (wr == 0) PG8_BAR; }
        E(acc, cur, wr, wc, fr, fq);
        if (!has_next) break;
#pragma unroll
        for (int a = 0; a < 2; ++a)
#pragma unroll
            for (int b = 0; b < 2; ++b)
#pragma unroll
                for (int m = 0; m < 4; ++m)
#pragma unroll
                    for (int n = 0; n < 2; ++n) acc[a][b][m][n] = (f32x4){0.f, 0.f, 0.f, 0.f};
        cur = nxt; cA = nA; cB = nB; ++ui;
        if constexpr (ALIGN_EPI) { if (wr == 1) PG8_BAR; }
    }
    PG8_WAIT_V(0);
    if constexpr (!ALIGN_EPI) { if (wr == 0) PG8_BAR; }
    PG8_BAR;
#undef PG8_SA
#undef PG8_SB
#undef PG8_STAGE
#undef PG8_LDA
#undef PG8_LDB
#undef PG8_MMA
#undef PG8_WAIT_V
#undef PG8_WAIT_L
#undef PG8_BAR
#undef PG8_SCHED
}
}

#define XB_TMO      128
#define XB_XCNT(j)  (256  + 64 * (j))
#define XB_XSUB(j)  (1280 + 64 * (j))
#define XB_XGEN(j)  (2304 + 64 * (j))
#define XB_TOP      3328
#define XB_TOPGEN   3392
#define XCD_BAR_WORDS 3456
#define XB_SPIN_CAP (1u << 18)

__device__ __forceinline__ unsigned xb_ld(unsigned* p)              { return __hip_atomic_load(p, __ATOMIC_RELAXED, __HIP_MEMORY_SCOPE_AGENT); }
__device__ __forceinline__ unsigned xb_add(unsigned* p, unsigned v) { return __hip_atomic_fetch_add(p, v, __ATOMIC_RELAXED, __HIP_MEMORY_SCOPE_AGENT); }
__device__ __forceinline__ unsigned xb_xcc_id() { return (unsigned)__builtin_amdgcn_s_getreg((3 << 11) | 20) & 0xFu; }
#define XB_SPIN(cond, bar) do { unsigned _sp = 0; while (cond) { __builtin_amdgcn_s_sleep(1); \
    if ((++_sp & 255u) == 0u) { if (xb_ld(&(bar)[XB_TMO])) break; if (_sp > XB_SPIN_CAP) { atomicAdd(&(bar)[XB_TMO], 1u); break; } } } } while (0)

struct XcdBarrier {
    unsigned* bar; unsigned x;
    volatile LAS unsigned* st;
};

__device__ __forceinline__ XcdBarrier xcd_barrier_post(unsigned* bar, volatile LAS unsigned* st) {
    XcdBarrier b; b.bar = bar; b.x = xb_xcc_id(); b.st = st;
    if (threadIdx.x == 0) (void)xb_add(&bar[XB_XCNT(b.x)], 1u);
    return b;
}
__device__ __forceinline__ void xcd_barrier_complete(unsigned* bar, unsigned x, unsigned& nloc, unsigned& nx) {
    const unsigned G = gridDim.x * gridDim.y * gridDim.z;
    unsigned sum, cnt, mine, sp = 0u;
    for (;;) {
        sum = 0u; cnt = 0u; mine = 0u;
#pragma unroll
        for (unsigned j = 0; j < 16; ++j) { const unsigned c = xb_ld(&bar[XB_XCNT(j)]); sum += c; cnt += (c > 0u) ? 1u : 0u; mine = (j == x) ? c : mine; }
        if (sum == G) break;
        __builtin_amdgcn_s_sleep(1);
        if ((++sp & 255u) == 0u) { if (xb_ld(&bar[XB_TMO])) break; if (sp > XB_SPIN_CAP) { atomicAdd(&bar[XB_TMO], 1u); break; } }
    }
    nloc = mine > 0u ? mine : 1u; nx = cnt > 0u ? cnt : 1u;
}

__device__ __forceinline__ void xcd_barrier(const XcdBarrier& b) {
    asm volatile("s_waitcnt vmcnt(0)" ::: "memory");
    __syncthreads();
    if (threadIdx.x == 0) {
        unsigned* bar = b.bar;
        __builtin_amdgcn_s_waitcnt(0);
        unsigned nloc = b.st[0], nx = b.st[1];
        if (nloc == 0u) { xcd_barrier_complete(bar, b.x, nloc, nx); b.st[0] = nloc; b.st[1] = nx; }
        const unsigned old = xb_add(&bar[XB_XSUB(b.x)], 1u);
        const unsigned gen = old / nloc;
        if (old + 1u == (gen + 1u) * nloc) {
            __builtin_amdgcn_fence(__ATOMIC_RELEASE, "agent");
            asm volatile("s_waitcnt vmcnt(0)" ::: "memory");
            const unsigned og = xb_add(&bar[XB_TOP], 1u);
            const unsigned tg = og / nx;
            if (og + 1u == (tg + 1u) * nx) xb_add(&bar[XB_TOPGEN], 1u);
            else XB_SPIN(xb_ld(&bar[XB_TOPGEN]) == tg, bar);
            __builtin_amdgcn_fence(__ATOMIC_ACQUIRE, "agent");
            xb_add(&bar[XB_XGEN(b.x)], 1u);
            asm volatile("s_waitcnt vmcnt(0)" ::: "memory");
        } else {
            XB_SPIN(xb_ld(&bar[XB_XGEN(b.x)]) == gen, bar);
            __builtin_amdgcn_fence(__ATOMIC_ACQUIRE, "agent");
            asm volatile("s_waitcnt vmcnt(0)" ::: "memory");
        }
    }
    __syncthreads();
}


template <int MODE, bool COMB, int NR>
__device__ __forceinline__ void ln_rows(const float* const (&sp)[NR], bool zero_src, float* dstf, bf16_t* dstb, f32x2* st, const float* g, const float* b, int lane,
                                        const bf16_t* sb, const float* pg, const float* pb, float scale) {
    f32x4 v[NR][8]; float sm[NR];
#pragma unroll
    for (int i = 0; i < NR; ++i)
#pragma unroll
        for (int j = 0; j < 8; ++j) v[i][j] = zero_src ? (f32x4){0.f, 0.f, 0.f, 0.f} : *(const f32x4*)(sp[i] + 4 * lane + 256 * j);
    if (COMB) {
        u32x2 sv[NR][8]; float ra[NR], rb[NR];
#pragma unroll
        for (int i = 0; i < NR; ++i)
#pragma unroll
            for (int j = 0; j < 8; ++j) sv[i][j] = *(const u32x2*)(sb + (size_t)i * D + 4 * lane + 256 * j);
#pragma unroll
        for (int i = 0; i < NR; ++i) { const f32x2 ms = st[i]; ra[i] = ALPHA * ms.y; rb[i] = -ms.x * ra[i]; }
#pragma unroll
        for (int j = 0; j < 8; ++j) {
            const f32x4 pgv = *(const f32x4*)(pg + 4 * lane + 256 * j), pbv = *(const f32x4*)(pb + 4 * lane + 256 * j) * ALPHA;
#pragma unroll
            for (int i = 0; i < NR; ++i) { const f32x4 s4 = {bf_lo(sv[i][j].x), bf_hi(sv[i][j].x), bf_lo(sv[i][j].y), bf_hi(sv[i][j].y)};
                v[i][j] = (v[i][j] * ra[i] + rb[i]) * pgv + pbv + s4 * scale;
                if (MODE == 0) *(f32x4*)(dstf + (size_t)i * D + 4 * lane + 256 * j) = v[i][j]; }
        }
    }
#pragma unroll
    for (int i = 0; i < NR; ++i) { float s = 0.f;
#pragma unroll
        for (int j = 0; j < 8; ++j) s += (v[i][j].x + v[i][j].y) + (v[i][j].z + v[i][j].w);
        sm[i] = s; }
    if (MODE == 1) {
#pragma unroll
        for (int i = 0; i < NR; ++i)
#pragma unroll
            for (int j = 0; j < 8; ++j) *(f32x4*)(dstf + (size_t)i * D + 4 * lane + 256 * j) = v[i][j];
    }
#pragma unroll
    for (int o = 1; o < 64; o <<= 1) {
#pragma unroll
        for (int i = 0; i < NR; ++i) sm[i] += __shfl_xor(sm[i], o); }
    float mean[NR], q[NR], rstd[NR];
#pragma unroll
    for (int i = 0; i < NR; ++i) { mean[i] = sm[i] * (1.f / D); float s2 = 0.f;
#pragma unroll
        for (int j = 0; j < 8; ++j) { v[i][j] = v[i][j] - mean[i]; s2 += (v[i][j].x * v[i][j].x + v[i][j].y * v[i][j].y) + (v[i][j].z * v[i][j].z + v[i][j].w * v[i][j].w); }
        q[i] = s2; }
#pragma unroll
    for (int o = 1; o < 64; o <<= 1) {
#pragma unroll
        for (int i = 0; i < NR; ++i) q[i] += __shfl_xor(q[i], o); }
#pragma unroll
    for (int i = 0; i < NR; ++i) rstd[i] = rsqrtf(q[i] * (1.f / D) + LN_EPS);
    if (MODE != 2) {
#pragma unroll
        for (int i = 0; i < NR; ++i) if (lane == i) st[i] = (f32x2){mean[i], rstd[i]};
    }
#pragma unroll
    for (int j = 0; j < 8; ++j) {
        const f32x4 gg = *(const f32x4*)(g + 4 * lane + 256 * j), bb = *(const f32x4*)(b + 4 * lane + 256 * j);
#pragma unroll
        for (int i = 0; i < NR; ++i) {
            const f32x4 y = v[i][j] * rstd[i] * gg + bb;
            if (MODE == 2) *(f32x4*)(dstf + (size_t)i * D + 4 * lane + 256 * j) = y;
            else { u32x2 w; w.x = cvt_pk_bf16(y.x, y.y); w.y = cvt_pk_bf16(y.z, y.w); *(u32x2*)(dstb + (size_t)i * D + 4 * lane + 256 * j) = w; }
        }
    }
}

__device__ __forceinline__ void transpose_item(const float* W, int K, int N, bf16_t* WT, int k0, int n0, int drow0, LAS float* scr, int lane) {
    float wv[32];
#pragma unroll
    for (int i = 0; i < 32; ++i) wv[i] = W[(size_t)(k0 + 2 * i + (lane >> 5)) * N + n0 + (lane & 31)];
#pragma unroll
    for (int i = 0; i < 32; ++i) scr[(2 * i + (lane >> 5)) * 33 + (lane & 31)] = wv[i];
    asm volatile("s_waitcnt lgkmcnt(0)" ::: "memory");
    const int c = lane & 7;
#pragma unroll
    for (int j = 0; j < 4; ++j) { const int n = (lane >> 3) + 8 * j; const LAS float* s = scr + (8 * c) * 33 + n;
        u32x4 o; o.x = cvt_pk_bf16(s[0 * 33], s[1 * 33]); o.y = cvt_pk_bf16(s[2 * 33], s[3 * 33]); o.z = cvt_pk_bf16(s[4 * 33], s[5 * 33]); o.w = cvt_pk_bf16(s[6 * 33], s[7 * 33]);
        *(u32x4*)(WT + (size_t)(drow0 + n) * K + k0 + 8 * c) = o; }
    asm volatile("s_waitcnt lgkmcnt(0)" ::: "memory");
}

__device__ __forceinline__ void convert_weights(const Args& a, int l, LAS unsigned char* lds, int part, int b0, int nb) {
    const int tid = ltid(), bid = lbid(), lane = tid & 63, wave = tid >> 6, G = gridDim.x;
    LAS float* scr = (LAS float*)(lds + wave * 8448);
    unsigned char* wb = a.ws + WS_W;
    const int gw = (bid - b0) * 8 + wave, NGW = nb * 8;
    constexpr int I_FF = (D / 64) * (FF / 32);
    constexpr int I_IN = (D / 64) * (DIN / 32);
    constexpr int I_OUT = (1536 / 64) * (D / 32);
    constexpr int NITEMS = 6 * I_FF + I_IN + I_OUT;
    for (int it = gw; it < NITEMS; it += NGW) {
        int r = it;
        if (r < 6 * I_FF) {
            const int which = r / I_FF; r -= which * I_FF;
            if ((which >= 3) != (part == 1)) continue;
            const int f = which / 3, kind = which % 3;
            const float* src = a.in[(f ? 25 : 5) + kind] + (size_t)l * D * FF;
            if (kind < 2) { const int nblk = FF / 32, kb = r / nblk, nb = r % nblk, n0 = nb * 32;
                transpose_item(src, D, FF, (bf16_t*)(wb + (f ? W_GU2 : W_GU1)), kb * 64, n0, (n0 >> 7) * 256 + kind * 128 + (n0 & 127), scr, lane); }
            else { const int nblk = D / 32, kb = r / nblk, nb = r % nblk;
                transpose_item(src, FF, D, (bf16_t*)(wb + (f ? W_D2 : W_D1)), kb * 64, nb * 32, nb * 32, scr, lane); }
            continue;
        }
        r -= 6 * I_FF;
        if (part == 1) break;
        if (r < I_IN) { const int nblk = DIN / 32, kb = r / nblk, nb = r % nblk;
            transpose_item(a.in[10] + (size_t)l * D * DIN, D, DIN, (bf16_t*)(wb + W_IN), kb * 64, nb * 32, nb * 32, scr, lane); continue; }
        r -= I_IN;
        { const int nblk = D / 32, kb = r / nblk, nb = r % nblk;
          transpose_item(a.in[22] + (size_t)l * D * D, D, D, (bf16_t*)(wb + W_OUT), kb * 64, nb * 32, nb * 32, scr, lane); }
    }
    if (part == 0)
    {
        const float* pw = a.in[20] + (size_t)l * 4 * 128 * 128; const float* ps = a.in[21] + (size_t)l * DPOOL; const float* wo = a.in[22] + (size_t)l * D * D;
        bf16_t* WT = (bf16_t*)(wb + W_OUT);
        for (int it = (bid - b0) * 512 + tid; it < 64 * D; it += nb * 512) {
            const int n = it % D, kq = __builtin_amdgcn_readfirstlane(it / D), gq = kq >> 4, i0 = (kq & 15) * 8;
            float accv[8];
#pragma unroll
            for (int e = 0; e < 8; ++e) accv[e] = 0.f;
#pragma unroll 2
            for (int j0 = 0; j0 < 128; j0 += 8) {
                float wv[8];
#pragma unroll
                for (int jj = 0; jj < 8; ++jj) wv[jj] = wo[(size_t)(1536 + gq * 128 + j0 + jj) * D + n] * ps[gq * 128 + j0 + jj];
#pragma unroll
                for (int jj = 0; jj < 8; ++jj)
#pragma unroll
                    for (int e = 0; e < 8; ++e) accv[e] += pw[(gq * 128 + i0 + e) * 128 + j0 + jj] * wv[jj];
            }
            u32x4 o; o.x = cvt_pk_bf16(accv[0], accv[1]); o.y = cvt_pk_bf16(accv[2], accv[3]); o.z = cvt_pk_bf16(accv[4], accv[5]); o.w = cvt_pk_bf16(accv[6], accv[7]);
            *(u32x4*)(WT + (size_t)n * D + 1536 + gq * 128 + i0) = o;
        }
    }
}

__device__ __forceinline__ float* xrow_ptr(const Args& a, int r) { return r < NTOK ? a.out + (size_t)r * D : (float*)(a.ws + WS_XM) + (size_t)(r - NTOK) * D; }

__device__ __forceinline__ void unpack8v(const u32x4 w, f32x4& lo, f32x4& hi) { lo = (f32x4){bf_lo(w.x), bf_hi(w.x), bf_lo(w.y), bf_hi(w.y)}; hi = (f32x4){bf_lo(w.z), bf_hi(w.z), bf_lo(w.w), bf_hi(w.w)}; }
template <int NR>
__device__ __forceinline__ void ln_comb(bf16_t* h, const bf16_t* sb, float scale, const float* g, const float* b, int lane) {
    u32x4 hv[NR][4], sv[NR][4]; f32x4 v[NR][4][2]; float sm[NR];
#pragma unroll
    for (int i = 0; i < NR; ++i)
#pragma unroll
        for (int j = 0; j < 4; ++j) { hv[i][j] = *(const u32x4*)(h + (size_t)i * D + 8 * lane + 512 * j); sv[i][j] = *(const u32x4*)(sb + (size_t)i * D + 8 * lane + 512 * j); }
#pragma unroll
    for (int i = 0; i < NR; ++i) { float s = 0.f;
#pragma unroll
        for (int j = 0; j < 4; ++j) { f32x4 h0, h1, s0, s1; unpack8v(hv[i][j], h0, h1); unpack8v(sv[i][j], s0, s1);
            v[i][j][0] = h0 * ALPHA + s0 * scale; v[i][j][1] = h1 * ALPHA + s1 * scale;
            s += ((v[i][j][0].x + v[i][j][0].y) + (v[i][j][0].z + v[i][j][0].w)) + ((v[i][j][1].x + v[i][j][1].y) + (v[i][j][1].z + v[i][j][1].w)); }
        sm[i] = s; }
#pragma unroll
    for (int o = 1; o < 64; o <<= 1) {
#pragma unroll
        for (int i = 0; i < NR; ++i) sm[i] += __shfl_xor(sm[i], o); }
    float q[NR], rstd[NR];
#pragma unroll
    for (int i = 0; i < NR; ++i) { const float mean = sm[i] * (1.f / D); float s2 = 0.f;
#pragma unroll
        for (int j = 0; j < 4; ++j)
#pragma unroll
            for (int e = 0; e < 2; ++e) { v[i][j][e] = v[i][j][e] - mean; s2 += (v[i][j][e].x * v[i][j][e].x + v[i][j][e].y * v[i][j][e].y) + (v[i][j][e].z * v[i][j][e].z + v[i][j][e].w * v[i][j][e].w); }
        q[i] = s2; }
#pragma unroll
    for (int o = 1; o < 64; o <<= 1) {
#pragma unroll
        for (int i = 0; i < NR; ++i) q[i] += __shfl_xor(q[i], o); }
#pragma unroll
    for (int i = 0; i < NR; ++i) rstd[i] = rsqrtf(q[i] * (1.f / D) + LN_EPS);
#pragma unroll
    for (int j = 0; j < 4; ++j) {
        const int c = 8 * lane + 512 * j;
        const f32x4 g0 = *(const f32x4*)(g + c), g1 = *(const f32x4*)(g + c + 4), b0 = *(const f32x4*)(b + c), b1 = *(const f32x4*)(b + c + 4);
#pragma unroll
        for (int i = 0; i < NR; ++i) { const f32x4 y0 = v[i][j][0] * rstd[i] * g0 + b0, y1 = v[i][j][1] * rstd[i] * g1 + b1;
            u32x4 w; w.x = cvt_pk_bf16(y0.x, y0.y); w.y = cvt_pk_bf16(y0.z, y0.w); w.z = cvt_pk_bf16(y1.x, y1.y); w.w = cvt_pk_bf16(y1.z, y1.w);
            *(u32x4*)(h + (size_t)i * D + c) = w; }
    }
}
template <int NR>
__device__ __forceinline__ void ln_in_rows(const float* const (&sp)[NR], bool zero_src, bf16_t* h, const float* g, const float* b, int lane) {
    f32x4 v[NR][4][2]; float sm[NR];
#pragma unroll
    for (int i = 0; i < NR; ++i)
#pragma unroll
        for (int j = 0; j < 4; ++j)
#pragma unroll
            for (int e = 0; e < 2; ++e) v[i][j][e] = zero_src ? (f32x4){0.f, 0.f, 0.f, 0.f} : *(const f32x4*)(sp[i] + 8 * lane + 512 * j + 4 * e);
#pragma unroll
    for (int i = 0; i < NR; ++i) { float s = 0.f;
#pragma unroll
        for (int j = 0; j < 4; ++j)
#pragma unroll
            for (int e = 0; e < 2; ++e) s += (v[i][j][e].x + v[i][j][e].y) + (v[i][j][e].z + v[i][j][e].w);
        sm[i] = s; }
#pragma unroll
    for (int o = 1; o < 64; o <<= 1) {
#pragma unroll
        for (int i = 0; i < NR; ++i) sm[i] += __shfl_xor(sm[i], o); }
    float q[NR], rstd[NR];
#pragma unroll
    for (int i = 0; i < NR; ++i) { const float mean = sm[i] * (1.f / D); float s2 = 0.f;
#pragma unroll
        for (int j = 0; j < 4; ++j)
#pragma unroll
            for (int e = 0; e < 2; ++e) { v[i][j][e] = v[i][j][e] - mean; s2 += (v[i][j][e].x * v[i][j][e].x + v[i][j][e].y * v[i][j][e].y) + (v[i][j][e].z * v[i][j][e].z + v[i][j][e].w * v[i][j][e].w); }
        q[i] = s2; }
#pragma unroll
    for (int o = 1; o < 64; o <<= 1) {
#pragma unroll
        for (int i = 0; i < NR; ++i) q[i] += __shfl_xor(q[i], o); }
#pragma unroll
    for (int i = 0; i < NR; ++i) rstd[i] = rsqrtf(q[i] * (1.f / D) + LN_EPS);
#pragma unroll
    for (int j = 0; j < 4; ++j) {
        const int c = 8 * lane + 512 * j;
        const f32x4 g0 = *(const f32x4*)(g + c), g1 = *(const f32x4*)(g + c + 4), b0 = *(const f32x4*)(b + c), b1 = *(const f32x4*)(b + c + 4);
#pragma unroll
        for (int i = 0; i < NR; ++i) { const f32x4 y0 = v[i][j][0] * rstd[i] * g0 + b0, y1 = v[i][j][1] * rstd[i] * g1 + b1;
            u32x4 w; w.x = cvt_pk_bf16(y0.x, y0.y); w.y = cvt_pk_bf16(y0.z, y0.w); w.z = cvt_pk_bf16(y1.x, y1.y); w.w = cvt_pk_bf16(y1.z, y1.w);
            *(u32x4*)(h + (size_t)i * D + c) = w; }
    }
}
__device__ __forceinline__ void ln_tail_row(bf16_t* h, const float* part, float scale, const float* g, const float* b, int lane) {
    f32x4 v[8]; float s = 0.f;
#pragma unroll
    for (int j = 0; j < 8; ++j) { const int c = 4 * lane + 256 * j; const u32x2 w = *(const u32x2*)(h + c);
        f32x4 p = *(const f32x4*)(part + c);
#pragma unroll
        for (int q = 1; q < 4; ++q) p = p + *(const f32x4*)(part + (size_t)q * 512 * D + c);
        const f32x4 h4 = {bf_lo(w.x), bf_hi(w.x), bf_lo(w.y), bf_hi(w.y)};
        v[j] = h4 * ALPHA + p * scale; s += (v[j].x + v[j].y) + (v[j].z + v[j].w); }
    const float mean = wave_sum(s) * (1.f / D); float s2 = 0.f;
#pragma unroll
    for (int j = 0; j < 8; ++j) { v[j] = v[j] - mean; s2 += (v[j].x * v[j].x + v[j].y * v[j].y) + (v[j].z * v[j].z + v[j].w * v[j].w); }
    const float rstd = rsqrtf(wave_sum(s2) * (1.f / D) + LN_EPS);
#pragma unroll
    for (int j = 0; j < 8; ++j) { const int c = 4 * lane + 256 * j; const f32x4 y = v[j] * rstd * *(const f32x4*)(g + c) + *(const f32x4*)(b + c);
        u32x2 w; w.x = cvt_pk_bf16(y.x, y.y); w.y = cvt_pk_bf16(y.z, y.w); *(u32x2*)(h + c) = w; }
}
__device__ __forceinline__ const float* in_row(const Args& a, int r) {
    if (r < 32768) return a.in[0] + (size_t)r * D;
    if (r < NTOK) return a.in[1] + (size_t)(r - 32768) * D;
    return a.in[2] + (size_t)((r - NTOK) & 15) * D;
}
__device__ __forceinline__ void ln_in_phase(const Args& a) {
    const int tid = ltid(), lane = tid & 63, gw = lbid() * 8 + (tid >> 6), NGW = gridDim.x * 8;
    bf16_t* hb = (bf16_t*)(a.ws + WS_HB); f32x2* st = (f32x2*)(a.ws + WS_ST);
    for (int r = 4 * gw; r < TP; r += 4 * NGW)
      { const float* const sp[4] = {in_row(a, r), in_row(a, r + 1), in_row(a, r + 2), in_row(a, r + 3)};
        ln_in_rows<4>(sp, r >= TREAL, hb + (size_t)r * D, a.in[3], a.in[4], lane); }
}
__device__ __forceinline__ void tail_fix_row(float* x, const float* part, const f32x2 ms, const float* pg, const float* pb, float scale, int lane) {
    const float ra = ALPHA * ms.y, rb = -ms.x * ra;
#pragma unroll
    for (int j = 0; j < 8; ++j) { const int c = 4 * lane + 256 * j;
        f32x4 p = *(const f32x4*)(part + c);
#pragma unroll
        for (int q = 1; q < 4; ++q) p = p + *(const f32x4*)(part + (size_t)q * 512 * D + c);
        const f32x4 v = *(const f32x4*)(x + c);
        *(f32x4*)(x + c) = (v * ra + rb) * *(const f32x4*)(pg + c) + *(const f32x4*)(pb + c) * ALPHA + p * scale; }
}
template <int MODE>
__device__ __forceinline__ void ln_phase(const Args& a, const float* g, const float* b, int nrows, float scale) {
    const int tid = ltid(), lane = tid & 63, gw = lbid() * 8 + (tid >> 6), NGW = gridDim.x * 8;
    bf16_t* hb = (bf16_t*)(a.ws + WS_HB); f32x2* st = (f32x2*)(a.ws + WS_ST);
    if (MODE == 2) {
        for (int r = 4 * gw; r < NTOK; r += 4 * NGW) { float* x = a.out + (size_t)r * D; const float* const sp[4] = {x, x + D, x + 2 * D, x + 3 * D};
            ln_rows<2, false, 4>(sp, false, x, nullptr, st, g, b, lane, nullptr, nullptr, nullptr, 0.f); }
    } else {
        const bf16_t* sbuf = (const bf16_t*)a.out;
        for (int r = 3 * gw; r < NTOK; r += 3 * NGW) ln_comb<3>(hb + (size_t)r * D, sbuf + (size_t)r * D, scale, g, b, lane);
        for (int r = NTOK + gw; r < nrows; r += NGW) ln_tail_row(hb + (size_t)r * D, (const float*)(a.ws + WS_PART) + (size_t)(r - NTOK) * D, scale, g, b, lane);
    }
}

constexpr int LRU_AS = 272;
constexpr int LRU_FS = 144;
constexpr int LRU_OFF_A = 0, LRU_OFF_HO = 64 * LRU_AS, LRU_OFF_LA = 2 * 64 * LRU_AS, LRU_OFF_LB = LRU_OFF_LA + 64 * LRU_FS * 4;
static_assert(LRU_OFF_LB + 64 * LRU_FS * 4 <= LDS_BYTES, "lru lds");

#define LRU_LOAD_RAW(J0) do { const int jA_ = (J0) + 4 * tg; _Pragma("unroll") for (int q_ = 0; q_ < 7; ++q_) { const int j_ = jA_ - 3 + q_; \
        if (j_ >= 0 && j_ < L) { const int p_ = dir ? (L - 1 - j_) : j_; raw[q_] = *(const u32x4*)(proj + (size_t)row_of(s, p_) * DIN + xcol + cg8); } \
        else raw[q_] = (u32x4){0u, 0u, 0u, 0u}; } } while (0)
#define LRU_CONV() do { _Pragma("unroll") for (int o_ = 0; o_ < 4; ++o_) { float y_[8]; \
        _Pragma("unroll") for (int e_ = 0; e_ < 8; ++e_) y_[e_] = cb[e_]; \
        _Pragma("unroll") for (int k_ = 0; k_ < 4; ++k_) { const u32x4 rw_ = raw[o_ + k_]; const unsigned w4_[4] = {rw_.x, rw_.y, rw_.z, rw_.w}; \
            _Pragma("unroll") for (int e_ = 0; e_ < 4; ++e_) { y_[2 * e_] += cw[k_][2 * e_] * bf_lo(w4_[e_]); y_[2 * e_ + 1] += cw[k_][2 * e_ + 1] * bf_hi(w4_[e_]); } } \
        u32x4 w_; w_.x = cvt_pk_bf16(y_[0], y_[1]); w_.y = cvt_pk_bf16(y_[2], y_[3]); w_.z = cvt_pk_bf16(y_[4], y_[5]); w_.w = cvt_pk_bf16(y_[6], y_[7]); \
        *(LAS u32x4*)(At + (4 * tg + o_) * LRU_AS + cg8 * 2) = w_; } } while (0)

__device__ __forceinline__ void lds_barrier() { asm volatile("s_waitcnt lgkmcnt(0)" ::: "memory"); __builtin_amdgcn_s_barrier(); asm volatile("" ::: "memory"); }
__device__ __forceinline__ void lru_item(const Args& a, int l, int item, LAS unsigned char* lds) {
    const int tid = ltid(), lane = tid & 63, wave = __builtin_amdgcn_readfirstlane(tid >> 6), fr = lane & 15, fq = lane >> 4;
    int s, rem;
    if (item < 64) { s = 16 + (item >> 4); rem = item & 15; } else { s = (item - 64) >> 4; rem = (item - 64) & 15; }
    const int hd = rem >> 1, dir = rem & 1, L = seq_len(s);
    const bf16_t* proj = (const bf16_t*)(a.ws + WS_BIG);
    bf16_t* hfb = (bf16_t*)(a.ws + WS_BIG + BIG_HFB);
    const size_t pbase = (size_t)(l * 2 + dir);
    bf16x8 wfa[4], wfx[4];
    {
        const float* wa = a.in[15] + (pbase * 8 + hd) * 128 * 128; const float* wx = a.in[17] + (pbase * 8 + hd) * 128 * 128;
        const int n = 16 * wave + fr;
#pragma unroll
        for (int ks = 0; ks < 4; ++ks) {
            unsigned pa[4], px[4];
#pragma unroll
            for (int e = 0; e < 4; ++e) { const int k = 32 * ks + 8 * fq + 2 * e;
                pa[e] = cvt_pk_bf16(wa[k * 128 + n], wa[(k + 1) * 128 + n]); px[e] = cvt_pk_bf16(wx[k * 128 + n], wx[(k + 1) * 128 + n]); }
            u32x4 ta = {pa[0], pa[1], pa[2], pa[3]}, tx = {px[0], px[1], px[2], px[3]};
            wfa[ks] = __builtin_bit_cast(bf16x8, ta); wfx[ks] = __builtin_bit_cast(bf16x8, tx);
        }
    }
    const int ecol = 16 * wave + fr;
    const float e_ba = a.in[16][pbase * DLRU + hd * 128 + ecol], e_bx = a.in[18][pbase * DLRU + hd * 128 + ecol];
    const float e_coef = -8.0f * log1pf(expf(-a.in[19][pbase * DLRU + hd * 128 + ecol]));
    const int cg8 = (tid & 15) * 8, tg = (tid >> 4) & 15; const bool cvw = tid >= 256;
    float cw[4][8], cb[8];
    {
        const float* cwp = a.in[13] + pbase * 4 * DLRU + hd * 128 + cg8; const float* cbp = a.in[14] + pbase * DLRU + hd * 128 + cg8;
#pragma unroll
        for (int k = 0; k < 4; ++k)
#pragma unroll
            for (int e = 0; e < 8; ++e) cw[k][e] = cwp[k * DLRU + e];
#pragma unroll
        for (int e = 0; e < 8; ++e) cb[e] = cbp[e];
    }
    const int xcol = 1536 + hd * 128;
    float hstate = 0.f;
    LAS unsigned char* At = lds + LRU_OFF_A; LAS unsigned char* HO = lds + LRU_OFF_HO;
    LAS float* LA = (LAS float*)(lds + LRU_OFF_LA); LAS float* LB = (LAS float*)(lds + LRU_OFF_LB);
    const int ntile = (L + 63) >> 6;
    u32x4 raw[7];
    lds_barrier();
    if (cvw) { LRU_LOAD_RAW(0); LRU_CONV();
    if (ntile > 1) LRU_LOAD_RAW(64); }
    lds_barrier();
    for (int t = 0; t < ntile; ++t) {
        const int j0 = t * 64;
        {
            f32x4 accA[4], accX[4]; bf16x8 af[4][4]; bf16_t xr[4][4];
#pragma unroll
            for (int rb = 0; rb < 4; ++rb)
#pragma unroll
                for (int ks = 0; ks < 4; ++ks) af[rb][ks] = *(const LAS bf16x8*)(At + (16 * rb + fr) * LRU_AS + (32 * ks + 8 * fq) * 2);
#pragma unroll
            for (int rb = 0; rb < 4; ++rb)
#pragma unroll
                for (int j = 0; j < 4; ++j) xr[rb][j] = *(const LAS bf16_t*)(At + (16 * rb + 4 * fq + j) * LRU_AS + ecol * 2);
            __builtin_amdgcn_sched_barrier(0);
#pragma unroll
            for (int rb = 0; rb < 4; ++rb) { accA[rb] = (f32x4){0.f, 0.f, 0.f, 0.f}; accX[rb] = (f32x4){0.f, 0.f, 0.f, 0.f}; }
#pragma unroll
            for (int ks = 0; ks < 4; ++ks)
#pragma unroll
                for (int rb = 0; rb < 4; ++rb) {
                    accA[rb] = __builtin_amdgcn_mfma_f32_16x16x32_bf16(af[rb][ks], wfa[ks], accA[rb], 0, 0, 0);
                    accX[rb] = __builtin_amdgcn_mfma_f32_16x16x32_bf16(af[rb][ks], wfx[ks], accX[rb], 0, 0, 0);
                }
#pragma unroll
            for (int rb = 0; rb < 4; ++rb)
#pragma unroll
                for (int j = 0; j < 4; ++j) {
                    const int tt = 16 * rb + 4 * fq + j;
                    const float xcv = bf1(xr[rb][j]);
                    const float r = fast_sigmoid(accA[rb][j] + e_ba), ig = fast_sigmoid(accX[rb][j] + e_bx);
                    const float la = e_coef * r;
                    const float av = __builtin_amdgcn_exp2f(1.44269504089f * la);
                    const float om = 1.0f - __builtin_amdgcn_exp2f(2.88539008178f * la);
                    const float bv = __builtin_amdgcn_sqrtf(fmaxf(om, 0.f)) * ig * xcv;
                    LA[tt * LRU_FS + ecol] = av; LB[tt * LRU_FS + ecol] = bv;
                }
        }
        lds_barrier();
        if (tid < 128) {
#pragma unroll 1
            for (int t0 = 0; t0 < 64; t0 += 16) {
                float av[16], bv[16];
#pragma unroll
                for (int i = 0; i < 16; ++i) { av[i] = LA[(t0 + i) * LRU_FS + tid]; bv[i] = LB[(t0 + i) * LRU_FS + tid]; }
#pragma unroll
                for (int i = 0; i < 16; ++i) { hstate = av[i] * hstate + bv[i]; av[i] = hstate; }
#pragma unroll
                for (int i = 0; i < 16; ++i) *(LAS bf16_t*)(HO + (t0 + i) * LRU_AS + tid * 2) = (bf16_t)(cvt_pk_bf16(av[i], 0.f) & 0xffffu);
            }
        }
        if (cvw && t + 1 < ntile) { LRU_CONV(); if (t + 2 < ntile) LRU_LOAD_RAW(j0 + 128); }
        lds_barrier();
        {
            const int tt = tid >> 3, part = tid & 7, j = j0 + tt;
            if (j < L) { const int p = dir ? (L - 1 - j) : j;
                const u32x4 v0 = *(const LAS u32x4*)(HO + tt * LRU_AS + part * 32), v1 = *(const LAS u32x4*)(HO + tt * LRU_AS + part * 32 + 16);
                bf16_t* o = hfb + (size_t)row_of(s, p) * D + dir * DLRU + hd * 128 + part * 16;
                *(u32x4*)o = v0; *(u32x4*)(o + 8) = v1; }
        }
    }
}
__device__ __forceinline__ void lru_phase(const Args& a, int l, LAS unsigned char* lds) {
    const int b = lbid(), G = gridDim.x;
    if (G == 256) { lru_item(a, l, b, lds); if (b >= 64 && b < 128) lru_item(a, l, b + 192, lds);
        if (b >= 128) { __syncthreads(); convert_weights(a, l, lds, 1, 128, 128); } }
    else { for (int it = b; it < 320; it += G) lru_item(a, l, it, lds); __syncthreads(); convert_weights(a, l, lds, 1, 0, G); }
}

__device__ __forceinline__ void unpack8(const u32x4 w, float (&f)[8]) { f[0] = bf_lo(w.x); f[1] = bf_hi(w.x); f[2] = bf_lo(w.y); f[3] = bf_hi(w.y); f[4] = bf_lo(w.z); f[5] = bf_hi(w.z); f[6] = bf_lo(w.w); f[7] = bf_hi(w.w); }
__device__ __forceinline__ u32x4 pack8(const float (&y)[8]) { u32x4 w; w.x = cvt_pk_bf16(y[0], y[1]); w.y = cvt_pk_bf16(y[2], y[3]); w.z = cvt_pk_bf16(y[4], y[5]); w.w = cvt_pk_bf16(y[6], y[7]); return w; }
__device__ __forceinline__ void ew_phase(const Args& a, int l, LAS unsigned char* lds) {
    const int tid = ltid(), q = tid & 255, sub = tid >> 8, G = gridDim.x;
    const bf16_t* proj = (const bf16_t*)(a.ws + WS_BIG);
    const bf16_t* hfb = (const bf16_t*)(a.ws + WS_BIG + BIG_HFB);
    bf16_t* cat = (bf16_t*)(a.ws + WS_BIG + BIG_HFB);
    LAS unsigned char* pl = lds + sub * (44 * 1024);
    LAS unsigned char* ul = pl + 23 * 1024;
    constexpr int NCH = 16 * 258 + 4 * 514;
    const int per = (NCH + G - 1) / G, c0 = lbid() * per, c1 = (c0 + per) < NCH ? (c0 + per) : NCH;
    const u32x4 Z4 = {0u, 0u, 0u, 0u};
    for (int cbase = c0; cbase < c1; cbase += 2) {
        const int ch = cbase + sub; const bool act = ch < c1;
        int s = 0, c = 0;
        if (act) { if (ch < 4128) { s = ch / 258; c = ch - s * 258; } else { const int t = ch - 4128; s = t / 514; c = t - s * 514; s += 16; } }
        const int L = seq_len(s), p0 = 8 * c, row0 = row_of(s, p0);
        u32x4 Gw[8], Fw[8], Kw[8];
        if (act && q < 64) {
#pragma unroll
            for (int j = 0; j < 8; ++j) Gw[j] = *(const u32x4*)(proj + (size_t)(row0 + j) * DIN + 8 * q);
        } else if (act && q < 192) {
            const int c8 = 8 * (q - 64);
#pragma unroll
            for (int j = 0; j < 8; ++j) { Gw[j] = *(const u32x4*)(proj + (size_t)(row0 + j) * DIN + 2560 + c8);
                Fw[j] = *(const u32x4*)(hfb + (size_t)(row0 + j) * D + c8); Kw[j] = *(const u32x4*)(hfb + (size_t)(row0 + j) * D + DLRU + c8); }
        }
        if (act) {
#pragma unroll
            for (int i = 0; i < 6; ++i) { const int piece = i * 256 + q;
                if (piece < 23 * 64) { const int rr = piece >> 6, cc = piece & 63, p = p0 - 8 + rr;
                    u32x4 v = Z4;
                    if (p >= 0 && p < L) v = *(const u32x4*)(proj + (size_t)row_of(s, p) * DIN + 3584 + cc * 8);
                    *(LAS u32x4*)(pl + rr * 1024 + cc * 16) = v; } }
#pragma unroll
            for (int i = 0; i < 3; ++i) { const int piece = i * 256 + q;
                if (piece < 10 * 64) { const int rr = piece >> 6, cc = piece & 63, p = p0 - 1 + rr;
                    float u[8];
                    if (p >= 0 && p < L) { const bf16_t* pr = proj + (size_t)row_of(s, p) * DIN + cc * 8; float t0[8], t1[8];
                        unpack8(*(const u32x4*)(pr + 512), t0); unpack8(*(const u32x4*)(pr + 1024), t1);
#pragma unroll
                        for (int e = 0; e < 8; ++e) u[e] = t0[e] * t1[e]; }
                    else {
#pragma unroll
                        for (int e = 0; e < 8; ++e) u[e] = 0.f; }
                    *(LAS f32x4*)(ul + rr * 2048 + cc * 32) = (f32x4){u[0], u[1], u[2], u[3]}; *(LAS f32x4*)(ul + rr * 2048 + cc * 32 + 16) = (f32x4){u[4], u[5], u[6], u[7]}; } }
        }
        asm volatile("s_waitcnt vmcnt(0)" ::: "memory");
        __syncthreads();
        if (act) {
        if (q < 64) {
            const int c8 = 8 * q;
            const float* cwp = a.in[11] + (size_t)l * 3 * DCONV + c8; const float* cbp = a.in[12] + (size_t)l * DCONV + c8;
            float w0[8], w1[8], w2[8], cbv[8];
#pragma unroll
            for (int e = 0; e < 8; ++e) { w0[e] = cwp[e]; w1[e] = cwp[DCONV + e]; w2[e] = cwp[2 * DCONV + e]; cbv[e] = cbp[e]; }
            const LAS unsigned char* uc = ul + q * 32;
            f32x4 ua0 = *(const LAS f32x4*)(uc), ua1 = *(const LAS f32x4*)(uc + 16), ub0 = *(const LAS f32x4*)(uc + 2048), ub1 = *(const LAS f32x4*)(uc + 2048 + 16);
#pragma unroll
            for (int j = 0; j < 8; ++j) {
                const f32x4 uc0 = *(const LAS f32x4*)(uc + (j + 2) * 2048), uc1 = *(const LAS f32x4*)(uc + (j + 2) * 2048 + 16);
                float Bg[8], y[8]; unpack8(Gw[j], Bg);
#pragma unroll
                for (int e = 0; e < 4; ++e) { y[e] = Bg[e] * (cbv[e] + w0[e] * ua0[e] + w1[e] * ub0[e] + w2[e] * uc0[e]);
                    y[4 + e] = Bg[4 + e] * (cbv[4 + e] + w0[4 + e] * ua1[e] + w1[4 + e] * ub1[e] + w2[4 + e] * uc1[e]); }
                *(u32x4*)(cat + (size_t)(row0 + j) * D + c8) = pack8(y);
                ua0 = ub0; ua1 = ub1; ub0 = uc0; ub1 = uc1;
            }
        } else if (q < 192) {
            const int c8 = 8 * (q - 64);
#pragma unroll
            for (int j = 0; j < 8; ++j) {
                float gt[8], hf[8], hb[8], y[8];
                unpack8(Gw[j], gt); unpack8(Fw[j], hf); unpack8(Kw[j], hb);
#pragma unroll
                for (int e = 0; e < 8; ++e) { const float x = gt[e]; const float z = 1.5957691216f * (x + 0.044715f * x * x * x); y[e] = x * fast_sigmoid(z) * (hf[e] + hb[e]); }
                *(u32x4*)(cat + (size_t)(row0 + j) * D + 512 + c8) = pack8(y);
            }
        } else {
            const int c8 = 8 * (q - 192), gq = c8 >> 7, hw = 1 << gq;
            const LAS unsigned char* pc = pl + c8 * 2;
            float sm[8], t0[8];
#pragma unroll
            for (int e = 0; e < 8; ++e) sm[e] = 0.f;
#pragma unroll
            for (int dd = -8; dd < 8; ++dd) { const float msk = (dd >= -hw && dd < hw) ? 1.0f : 0.0f;
                unpack8(*(const LAS u32x4*)(pc + (8 + dd) * 1024), t0);
#pragma unroll
                for (int e = 0; e < 8; ++e) sm[e] += msk * t0[e]; }
#pragma unroll
            for (int j = 0; j < 8; ++j) {
                const int p = p0 + j;
                const int lo = (p - hw) > 0 ? (p - hw) : 0, hi = (p + hw - 1) < (L - 1) ? (p + hw - 1) : (L - 1);
                const float inv = 1.0f / (float)(hi - lo + 1);
                float y[8];
                unpack8(*(const LAS u32x4*)(pc + (8 + j) * 1024), t0);
#pragma unroll
                for (int e = 0; e < 8; ++e) y[e] = sm[e] * inv - t0[e];
                *(u32x4*)(cat + (size_t)(row0 + j) * D + 1536 + c8) = pack8(y);
                if (j < 7) {
                    float t1[8];
                    unpack8(*(const LAS u32x4*)(pc + (8 + j - hw) * 1024), t0); unpack8(*(const LAS u32x4*)(pc + (8 + j + hw) * 1024), t1);
#pragma unroll
                    for (int e = 0; e < 8; ++e) sm[e] += t1[e] - t0[e];
                }
            }
        }
        }
        __syncthreads();
    }
}

__device__ __forceinline__ void fill_gb(LAS unsigned char* lds, const float* g, const float* b) {
    const int tid = ltid(); LAS float* gb = (LAS float*)(lds + LDS_GB);
    *(LAS f32x4*)(gb + 4 * tid) = *(const f32x4*)(g + 4 * tid); *(LAS f32x4*)(gb + D + 4 * tid) = *(const f32x4*)(b + 4 * tid) * ALPHA;
    __syncthreads();
}
constexpr int NPHASE = 1 + 11 * DEPTH;
__global__ void __launch_bounds__(512, 2) fwd_megakernel(Args a) {
    extern __shared__ __attribute__((aligned(16))) unsigned char shm[];
    LAS unsigned char* lds = (LAS unsigned char*)shm;
    const int G = gridDim.x;
    bf16_t* hb = (bf16_t*)(a.ws + WS_HB);
    bf16_t* big = (bf16_t*)(a.ws + WS_BIG);
    unsigned char* wb = a.ws + WS_W;
    float* xm = (float*)(a.ws + WS_XM);
    volatile LAS unsigned* misc = (volatile LAS unsigned*)(lds + LDS_GB + 16384);
    if (threadIdx.x < 4) misc[threadIdx.x] = 0u;
    __syncthreads();
    const XcdBarrier bar = xcd_barrier_post((unsigned*)(a.ws + WS_BAR), misc);
    for (int ph = a.ph_lo; ph < a.ph_hi; ++ph) {
        if (ph == a.ph_lo + 1) cg::this_grid().sync();
        else if (ph > a.ph_lo) xcd_barrier(bar);
        if (ph == 0) { for (int rep = 0; rep < (((PROBE_REP >> 11) & 1) ? 2 : 1); ++rep) { convert_weights(a, 0, lds, 0, 0, G); ln_in_phase(a); } continue; }
        const int l = (ph - 1) / 11, k = (ph - 1) % 11;
        for (int rep = 0; rep < (((PROBE_REP >> k) & 1) ? 2 : 1); ++rep) {
        const bool lastl = (l == DEPTH - 1);
        pg8::StaticOrder S;
        switch (k) {
        case 0: case 8: {
            const int M = (k == 8 && lastl) ? NTOK : TP;
            pg8::Gemm g{hb, (const bf16_t*)(wb + (k == 0 ? W_GU1 : W_GU2)), M, 2 * FF, D, D}; S.init(M, 2 * FF, G, lbid());
            pg8::EpiSwiGLU E{big, FF};
            pg8::gemm_phase<pg8::EpiSwiGLU>(lds, g, S, E);
        } break;
        case 1: case 9: {
            pg8::Gemm g{big, (const bf16_t*)(wb + (k == 1 ? W_D1 : W_D2)), NTOK, D, FF, FF}; S.init(NTOK, D, G, lbid());
            const float* lg = (k == 1) ? (l == 0 ? a.in[3] : a.in[28] + (l - 1) * D) : a.in[23] + l * D;
            const float* lb = (k == 1) ? (l == 0 ? a.in[4] : a.in[29] + (l - 1) * D) : a.in[24] + l * D;
            if (k == 9 && lastl) { pg8::EpiZ EZ{a.out, hb}; pg8::gemm_phase<pg8::EpiZ>(lds, g, S, EZ); }
            else { pg8::EpiBf16 E{(bf16_t*)a.out, D}; pg8::gemm_phase<pg8::EpiBf16>(lds, g, S, E); }
            if (!(k == 9 && lastl)) {
                pg8::Gemm gt{big, (const bf16_t*)(wb + (k == 1 ? W_D1 : W_D2)), TP, D, FF / 4, FF}; pg8::TailOrder T{G, lbid()};
                pg8::EpiPartial EP{(float*)(a.ws + WS_PART)};
                pg8::gemm_phase<pg8::EpiPartial, pg8::TailOrder>(lds, gt, T, EP);
            }
        } break;
        case 2: ln_phase<0>(a, a.in[8] + l * D, a.in[9] + l * D, TP, 0.5f); break;
        case 3: {
            pg8::Gemm g{hb, (const bf16_t*)(wb + W_IN), TP, DIN, D, D}; S.init(TP, DIN, G, lbid());
            pg8::EpiBf16 E{big, DIN};
            pg8::gemm_phase<pg8::EpiBf16>(lds, g, S, E);
        } break;
#ifndef PHM
#define PHM 0xfff
#endif
        case 4: if (PHM & 16) lru_phase(a, l, lds); break;
        case 5: if (PHM & 32) ew_phase(a, l, lds); break;
        case 6: {
            const bf16_t* cat = (const bf16_t*)(a.ws + WS_BIG + BIG_HFB);
            pg8::Gemm g{cat, (const bf16_t*)(wb + W_OUT), NTOK, D, D, D}; S.init(NTOK, D, G, lbid());
            pg8::EpiBf16 E{(bf16_t*)a.out, D};
            pg8::gemm_phase<pg8::EpiBf16>(lds, g, S, E);
            if (!lastl) {
                pg8::Gemm gt{cat, (const bf16_t*)(wb + W_OUT), TP, D, D / 4, D}; pg8::TailOrder T{G, lbid()};
                pg8::EpiPartial EP{(float*)(a.ws + WS_PART)};
                pg8::gemm_phase<pg8::EpiPartial, pg8::TailOrder>(lds, gt, T, EP);
            }
        } break;
        case 7: ln_phase<0>(a, a.in[23] + l * D, a.in[24] + l * D, lastl ? NTOK : TP, 1.0f); break;
        default: {
            if (lastl) ln_phase<2>(a, a.in[28] + l * D, a.in[29] + l * D, NTOK, 0.f);
            else { ln_phase<0>(a, a.in[28] + l * D, a.in[29] + l * D, TP, 0.5f); convert_weights(a, l + 1, lds, 0, 0, G); }
        } break;
        }
        }
    }
}

extern "C" void kernel_launch(void* const* d_in, const int* in_sizes, int n_in, void* d_out, int out_size, void* d_ws, size_t ws_size, hipStream_t stream) {
    static int grid = 0;
    if (grid == 0) {
        int dev = 0, cus = 0, per_cu = 0;
        if (n_in != 30 || out_size != NTOK * D || ws_size < WS_TOTAL) { fprintf(stderr, "kernel_launch: unexpected shapes (n_in %d out %d ws %zu need %zu)\n", n_in, out_size, ws_size, (size_t)WS_END); }
        hipGetDevice(&dev);
        hipDeviceGetAttribute(&cus, hipDeviceAttributeMultiprocessorCount, dev);
        hipFuncSetAttribute((const void*)fwd_megakernel, hipFuncAttributeMaxDynamicSharedMemorySize, LDS_BYTES);
        hipOccupancyMaxActiveBlocksPerMultiprocessor(&per_cu, (const void*)fwd_megakernel, 512, LDS_BYTES);
        if (per_cu < 1) { fprintf(stderr, "kernel_launch: occupancy query says %d blocks per CU\n", per_cu); per_cu = 1; }
        (void)hipGetLastError();
        grid = cus * 1;
        fprintf(stderr, "kernel_launch: grid %d (per_cu %d)\n", grid, per_cu);
    }
    hipMemsetAsync((char*)d_ws + WS_BAR, 0, 16384, stream);
    Args a{};
    for (int i = 0; i < 30; ++i) a.in[i] = (const float*)d_in[i];
    a.out = (float*)d_out; a.ws = (unsigned char*)d_ws;
#if MK_MULTI
    for (int ph = 0; ph < NPHASE; ++ph) {
        a.ph_lo = ph; a.ph_hi = ph + 1;
        hipLaunchKernelGGL(fwd_megakernel, dim3(grid), dim3(512), LDS_BYTES, stream, a);
    }
#else
    a.ph_lo = 0; a.ph_hi = NPHASE;
    void* params[] = {&a};
    hipError_t e = hipLaunchCooperativeKernel((const void*)fwd_megakernel, dim3(grid), dim3(512), params, LDS_BYTES, stream);
    if (e != hipSuccess) fprintf(stderr, "cooperative launch failed: %s (grid %d)\n", hipGetErrorString(e), grid);
#endif
}
```
